# Optimizing an MI355X kernel written in HIP

```python
import math
import jax, jax.numpy as jnp
from jax import lax
import numpy as np

D_MODEL = 2048
BATCH = 1
SEQ = 8192
DEPTH = 1

HEAD_DIM = 64
MOBA_HEADS = 16
MOBA_BLOCK = 256
MOBA_TOPK = 3
MOBA_Q_CHUNK = 128
SWA_Q_HEADS = 16
SWA_KV_HEADS = 4
SWA_WINDOW = 128
SWA_BLOCK = 128
N_GROUPS = 4
EXPERTS_PER_GROUP = 8
N_EXPERTS = N_GROUPS * EXPERTS_PER_GROUP
EXPERT_TOP_K = 2
D_EXPERT = D_MODEL // 4
MOE_BLOCK = 128
RMS_EPS = 1e-6

MOBA_W = MOBA_HEADS * HEAD_DIM
SWA_Q_W = SWA_Q_HEADS * HEAD_DIM
SWA_KV_W = SWA_KV_HEADS * HEAD_DIM
IN_SIZES = [MOBA_W, MOBA_W, MOBA_W, SWA_Q_W, SWA_KV_W, SWA_KV_W, D_MODEL, D_MODEL]
IN_COLS = sum(IN_SIZES)

kernel_name = "hybrid_moba_swa_sink_hiermoe_block"


def rmsnorm(x, g):
    x32 = x.astype(jnp.float32)
    y = x32 * lax.rsqrt(jnp.mean(x32 * x32, axis=-1, keepdims=True) + RMS_EPS)
    return y.astype(x.dtype) * g


def alibi_slopes(n):
    return jnp.exp2(-8.0 * jnp.arange(1, n + 1, dtype=jnp.float32) / n)


def moba_attention(q, k, v, slopes):
    B, S, H, Dh = q.shape
    BS, QC = MOBA_BLOCK, MOBA_Q_CHUNK
    s_pad = -(-S // BS) * BS
    q, k, v = (jnp.swapaxes(t, 1, 2) for t in (q, k, v))
    if s_pad != S:
        pad = ((0, 0), (0, 0), (0, s_pad - S), (0, 0))
        q, k, v = (jnp.pad(t, pad) for t in (q, k, v))
    nb = s_pad // BS
    n_top = min(MOBA_TOPK, nb)
    scale = Dh ** -0.5
    kb = k.reshape(B, H, nb, BS, Dh)
    vb = v.reshape(B, H, nb, BS, Dh)
    k_mean = jnp.mean(kb.astype(jnp.float32), axis=3)
    gate = jnp.einsum('bhsd,bhnd->bhsn', q.astype(jnp.float32), k_mean)
    q_blk = jnp.arange(s_pad) // BS
    past = jnp.arange(nb)[None, :] < q_blk[:, None]
    gate = jnp.where(past, gate, -jnp.inf)
    _, sel = lax.top_k(gate, n_top)
    valid = sel < q_blk[:, None]
    nc = s_pad // QC
    to_chunks = lambda t: jnp.moveaxis(t.reshape(B, H, nc, QC, *t.shape[3:]), 2, 0)
    q_c, sel_c, valid_c = to_chunks(q), to_chunks(sel), to_chunks(valid)
    bi = jnp.arange(B)[:, None, None, None]
    hi = jnp.arange(H)[None, :, None, None]
    sl5 = slopes[None, :, None, None, None]
    sl4 = slopes[None, :, None, None]

    def chunk_fn(args):
        ci, qc, selc, validc = args
        t = ci * QC + jnp.arange(QC)
        blk = (ci * QC) // BS
        k_sel = kb[bi, hi, selc]
        v_sel = vb[bi, hi, selc]
        s_past = jnp.einsum('bhqd,bhqjkd->bhqjk', qc, k_sel).astype(jnp.float32) * scale
        key_pos = selc[..., None] * BS + jnp.arange(BS)
        dist = (t[:, None, None] - key_pos).astype(jnp.float32)
        s_past = jnp.where(validc[..., None], s_past - sl5 * dist, -jnp.inf)
        s_past = s_past.reshape(B, H, QC, n_top * BS)
        k_own = lax.dynamic_index_in_dim(kb, blk, axis=2, keepdims=False)
        v_own = lax.dynamic_index_in_dim(vb, blk, axis=2, keepdims=False)
        s_own = jnp.einsum('bhqd,bhkd->bhqk', qc, k_own).astype(jnp.float32) * scale
        d_own = (t[:, None] - (blk * BS + jnp.arange(BS))[None, :]).astype(jnp.float32)
        s_own = jnp.where(d_own >= 0, s_own - sl4 * d_own, -jnp.inf)
        p = jax.nn.softmax(jnp.concatenate([s_past, s_own], axis=-1), axis=-1)
        p_past = p[..., :n_top * BS].reshape(B, H, QC, n_top, BS).astype(v.dtype)
        p_own = p[..., n_top * BS:].astype(v.dtype)
        return (jnp.einsum('bhqjk,bhqjkd->bhqd', p_past, v_sel)
                + jnp.einsum('bhqk,bhkd->bhqd', p_own, v_own))

    o = lax.map(chunk_fn, (jnp.arange(nc), q_c, sel_c, valid_c))
    o = jnp.moveaxis(o, 0, 2).reshape(B, H, s_pad, Dh)[:, :, :S]
    return jnp.swapaxes(o, 1, 2).reshape(B, S, H * Dh)


def swa_sink_attention(q, k, v, sinks, slopes):
    B, S, Hq, Dh = q.shape
    Hkv = k.shape[2]
    G = Hq // Hkv
    W = SWA_BLOCK
    nb = S // W
    scale = Dh ** -0.5
    qb = q.reshape(B, nb, W, Hkv, G, Dh)
    kb = k.reshape(B, nb, W, Hkv, Dh)
    vb = v.reshape(B, nb, W, Hkv, Dh)
    shift = lambda t: jnp.pad(t[:, :-1], ((0, 0), (1, 0), (0, 0), (0, 0), (0, 0)))
    kk = jnp.concatenate([shift(kb), kb], axis=2)
    vv = jnp.concatenate([shift(vb), vb], axis=2)
    s = jnp.einsum('bnqhgd,bnkhd->bhgnqk', qb, kk).astype(jnp.float32) * scale
    dist = (jnp.arange(W)[:, None] + W - jnp.arange(2 * W)[None, :])
    in_win = (dist >= 0) & (dist < SWA_WINDOW)
    blk_ok = (jnp.arange(nb)[:, None, None] > 0) | (jnp.arange(2 * W)[None, None, :] >= W)
    mask = in_win[None] & blk_ok
    sl = slopes.reshape(Hkv, G)[:, :, None, None, None]
    s = jnp.where(mask, s - sl * dist.astype(jnp.float32), -jnp.inf)
    sink = jnp.broadcast_to(sinks.reshape(Hkv, G, 1, 1, 1).astype(jnp.float32), s.shape[:-1] + (1,))
    p = jax.nn.softmax(jnp.concatenate([s, sink], axis=-1), axis=-1)[..., :-1]
    o = jnp.einsum('bhgnqk,bnkhd->bnqhgd', p.astype(v.dtype), vv)
    return o.reshape(B, S, Hq * Dh)


def token_mixer(h, w_in, sinks, w_o_moba, w_o_swa, w_out, slopes_moba, slopes_swa):
    B, S, _ = h.shape
    offs = [int(o) for o in np.cumsum(IN_SIZES)[:-1]]
    qA, kA, vA, qB, kB, vB, gA, gB = jnp.split(h @ w_in, offs, axis=-1)
    heads = lambda t, n: t.reshape(B, S, n, HEAD_DIM)
    oA = moba_attention(heads(qA, MOBA_HEADS), heads(kA, MOBA_HEADS), heads(vA, MOBA_HEADS), slopes_moba)
    oB = swa_sink_attention(heads(qB, SWA_Q_HEADS), heads(kB, SWA_KV_HEADS), heads(vB, SWA_KV_HEADS),
                            sinks, slopes_swa)
    y = jax.nn.sigmoid(gA) * (oA @ w_o_moba) + jax.nn.sigmoid(gB) * (oB @ w_o_swa)
    return y @ w_out


def hier_moe(h, w_rg, b_rg, w_re, b_re, w_gate, w_up, w_down):
    B, S, D = h.shape
    T = B * S
    E, K, BLK = EXPERTS_PER_GROUP, EXPERT_TOP_K, MOE_BLOCK
    xt = h.reshape(T, D)
    g_logits = (xt @ w_rg).astype(jnp.float32) + b_rg
    g_sel = jnp.argmax(g_logits, axis=-1)
    g_w = jnp.take_along_axis(jax.nn.softmax(g_logits, axis=-1), g_sel[:, None], axis=-1)
    e_logits = ((xt @ w_re).astype(jnp.float32) + b_re).reshape(T, N_GROUPS, E)
    e_logits = jnp.take_along_axis(e_logits, g_sel[:, None, None], axis=1)[:, 0]
    e_top, e_idx = lax.top_k(e_logits, K)
    e_w = jax.nn.softmax(e_top, axis=-1) * g_w
    eid = (g_sel[:, None] * E + e_idx).reshape(-1)
    tok = jnp.repeat(jnp.arange(T), K)
    wts = e_w.reshape(-1)
    A = T * K
    order = jnp.argsort(eid)
    eid_s, tok_s, w_s = eid[order], tok[order], wts[order]
    counts = jnp.zeros((N_EXPERTS,), jnp.int32).at[eid].add(1)
    start = jnp.cumsum(counts) - counts
    padded = ((counts + BLK - 1) // BLK) * BLK
    pend = jnp.cumsum(padded)
    pstart = pend - padded
    dest = pstart[eid_s] + (jnp.arange(A) - start[eid_s])
    n_blocks = -(-A // BLK) + N_EXPERTS
    P = n_blocks * BLK
    buf_tok = jnp.zeros((P,), jnp.int32).at[dest].set(tok_s.astype(jnp.int32))
    buf_w = jnp.zeros((P,), h.dtype).at[dest].set(w_s.astype(h.dtype))
    block_expert = jnp.minimum(jnp.searchsorted(pend, jnp.arange(n_blocks) * BLK, side='right'),
                               N_EXPERTS - 1)
    xb = xt[buf_tok].reshape(n_blocks, BLK, D)

    def expert_block(args):
        xblk, e = args
        return (jax.nn.silu(xblk @ w_gate[e]) * (xblk @ w_up[e])) @ w_down[e]

    yb = lax.map(expert_block, (xb, block_expert)).reshape(P, D) * buf_w[:, None]
    return jax.ops.segment_sum(yb, buf_tok, num_segments=T).reshape(B, S, D)


def setup_inputs(seed: int = 0) -> dict:
    key = jax.random.key(seed)
    ks = jax.random.split(key, 20)
    L, D = DEPTH, D_MODEL
    f32 = jnp.float32
    nrm = lambda k, shape, fan_in: jax.random.normal(k, shape, f32) * fan_in ** -0.5
    gain = lambda k: 1.0 + 0.05 * jax.random.normal(k, (L, D), f32)
    return {
        "x": jax.random.normal(ks[0], (BATCH, SEQ, D), f32),
        "c": jax.random.normal(ks[1], (BATCH, D), f32),
        "w_ada": 0.5 * nrm(ks[2], (L, D, 6 * D), D),
        "b_ada": 0.02 * jax.random.normal(ks[3], (L, 6 * D), f32),
        "g_pre_mix": gain(ks[4]),
        "g_post_mix": gain(ks[5]),
        "w_in": nrm(ks[6], (L, D, IN_COLS), D),
        "swa_sinks": 0.5 * jax.random.normal(ks[7], (L, SWA_Q_HEADS), f32),
        "w_o_moba": nrm(ks[8], (L, MOBA_W, D), MOBA_W),
        "w_o_swa": nrm(ks[9], (L, SWA_Q_W, D), SWA_Q_W),
        "w_out": nrm(ks[10], (L, D, D), D),
        "g_pre_ffn": gain(ks[11]),
        "g_post_ffn": gain(ks[12]),
        "w_router_group": nrm(ks[13], (L, D, N_GROUPS), D),
        "b_router_group": 0.01 * jax.random.normal(ks[14], (L, N_GROUPS), f32),
        "w_router_expert": nrm(ks[15], (L, D, N_EXPERTS), D),
        "b_router_expert": 0.01 * jax.random.normal(ks[16], (L, N_EXPERTS), f32),
        "w_gate": nrm(ks[17], (L, N_EXPERTS, D, D_EXPERT), D),
        "w_up": nrm(ks[18], (L, N_EXPERTS, D, D_EXPERT), D),
        "w_down": nrm(ks[19], (L, N_EXPERTS, D_EXPERT, D), D_EXPERT),
    }


def reference(x, c, w_ada, b_ada, g_pre_mix, g_post_mix, w_in, swa_sinks, w_o_moba, w_o_swa, w_out,
              g_pre_ffn, g_post_ffn, w_router_group, b_router_group, w_router_expert, b_router_expert,
              w_gate, w_up, w_down):
    slopes_moba = alibi_slopes(MOBA_HEADS)
    slopes_swa = alibi_slopes(SWA_Q_HEADS)
    cond = jax.nn.silu(c)
    for l in range(DEPTH):
        mod = cond @ w_ada[l] + b_ada[l]
        sh_m, sc_m, gt_m, sh_f, sc_f, gt_f = (m[:, None, :] for m in jnp.split(mod, 6, axis=-1))
        h = rmsnorm(x, g_pre_mix[l]) * (1.0 + sc_m) + sh_m
        y = token_mixer(h, w_in[l], swa_sinks[l], w_o_moba[l], w_o_swa[l], w_out[l], slopes_moba, slopes_swa)
        x = x + gt_m * rmsnorm(y, g_post_mix[l])
        h = rmsnorm(x, g_pre_ffn[l]) * (1.0 + sc_f) + sh_f
        y = hier_moe(h, w_router_group[l], b_router_group[l], w_router_expert[l], b_router_expert[l],
                     w_gate[l], w_up[l], w_down[l])
        x = x + gt_f * rmsnorm(y, g_post_ffn[l])
    return x
```

```cpp
#include <hip/hip_runtime.h>
#include <cstdio>
#include <cstdint>
#include <cmath>

#ifndef MK_N_LAUNCHES
#define MK_N_LAUNCHES 12
#endif
#ifndef FAST_GEMM
#define FAST_GEMM 0
#endif
#ifndef FAST_ATTN
#define FAST_ATTN 0
#endif
namespace pg8 {
#define PG8_LAS __attribute__((address_space(3)))
typedef unsigned short bf16_t;
typedef short bf16x8 __attribute__((ext_vector_type(8)));
typedef float f32x4 __attribute__((ext_vector_type(4)));
typedef unsigned u32x4 __attribute__((ext_vector_type(4)));
constexpr int BM = 256, BK = 64, HALF = 128, HTB = HALF * BK * 2  , STAGE_BYTES = 8 * HTB, NXCD = 8, WGM = 8;

__host__ __device__ __forceinline__ int lds_byte(int r, int c) { const int st = (r >> 4) * 2 + (c >> 5), rr = r & 15, cc = c & 31, ob = rr * 64 + cc * 2; return st * 1024 + (ob ^ (((ob >> 9) & 1) << 5)); }
__host__ __device__ __forceinline__ void stage_rc(int b, int& R, int& C) { const int st = b / 1024, sb = b % 1024, swz = sb ^ (((sb >> 9) & 1) << 5); R = (st >> 1) * 16 + swz / 64; C = (st & 1) * 32 + (swz % 64) / 2; }
__host__ __device__ __forceinline__ int perm32(int rho) { const int n = rho >> 4, i = rho & 15; return 8 * (i >> 2) + 4 * n + (i & 3); }

struct Unit { int pm, pn; };
struct Gemm { const bf16_t* A; const bf16_t* Bt; int M, N, K; };

struct StaticOrder {
    int nM, nN, nwg, G, c;
    __host__ __device__ void init(int M, int N, int G_, int c_) { nM = M / BM; nN = N / BM; nwg = nM * nN; G = G_; c = c_; }
    __host__ __device__ bool next(int i, Unit& u) const {
        const long L = (long)i * G + c; if (L >= nwg) return false;
        int wgid = (int)L; { const int q = nwg / NXCD, r = nwg % NXCD, xcd = wgid % NXCD, off = wgid / NXCD; wgid = (xcd < r ? xcd * (q + 1) : r * (q + 1) + (xcd - r) * q) + off; }
        const int nig = WGM * nN, gid = wgid / nig, fm = gid * WGM, gsz = (nM - fm) < WGM ? (nM - fm) : WGM;
        u.pm = fm + ((wgid % nig) % gsz); u.pn = (wgid % nig) / gsz; return true;
    }
    __device__ __forceinline__ void a_ready(const Unit&) const {}
    __device__ __forceinline__ void done(const Unit&) const {}
};

__device__ __forceinline__ unsigned cvt_pk_bf16(float lo, float hi) { unsigned r; asm volatile("v_cvt_pk_bf16_f32 %0, %1, %2" : "=v"(r) : "v"(lo), "v"(hi)); return r; }
template <class Epi, class Sched, bool ALIGN_EPI = false, bool SP2 = false>
__device__ __forceinline__ void gemm_phase(PG8_LAS unsigned char* lds, const Gemm g, const Sched& S, const Epi& E) {
    const int tid = threadIdx.x, wid = __builtin_amdgcn_readfirstlane(tid >> 6), lane = tid & 63, wr = wid >> 2, wc = wid & 3, fr = lane & 15, fq = lane >> 4;
    const int K = g.K, nt = K / BK;
    unsigned voffA[2], voffB[2];
#pragma unroll
    for (int i = 0; i < 2; ++i) { int R, C; stage_rc(tid * 16 + i * 8192, R, C); const int Rb = Epi::PERM ? ((R & ~31) + perm32(R & 31)) : R;
        voffA[i] = (unsigned)(R * K + C) * 2u; voffB[i] = (unsigned)(Rb * K + C) * 2u; }
    const size_t kstep = (size_t)(BK * 2);
    const size_t hstep = (size_t)HALF * K * 2;
    const size_t tstep = 2 * hstep;
    const unsigned ldsw = (unsigned)wid * 1024u;
    const int aoff = lds_byte(wr * 64 + fr, fq * 8), boff = lds_byte(wc * 32 + fr, fq * 8);
#define PG8_SA(b, h) (((b) * 2 + (h)) * HTB)
#define PG8_SB(b, h) ((4 + (b) * 2 + (h)) * HTB)
#define PG8_STAGE(bufoff, gbase, voff) do { _Pragma("unroll") for (int _i = 0; _i < 2; ++_i) \
        __builtin_amdgcn_global_load_lds((const unsigned*)((const char*)(gbase) + (voff)[_i]), (PG8_LAS unsigned*)(lds + (bufoff) + ldsw + _i * 8192), 16, 0, 0); } while (0)
#define PG8_LDA(dst, b, h) do { _Pragma("unroll") for (int m = 0; m < 4; ++m) _Pragma("unroll") for (int k = 0; k < 2; ++k) dst[m][k] = *(const PG8_LAS bf16x8*)(lds + PG8_SA(b, h) + aoff + m * 2048 + k * 1024); } while (0)
#define PG8_LDB(dst, b, h) do { _Pragma("unroll") for (int n = 0; n < 2; ++n) _Pragma("unroll") for (int k = 0; k < 2; ++k) dst[n][k] = *(const PG8_LAS bf16x8*)(lds + PG8_SB(b, h) + boff + n * 2048 + k * 1024); } while (0)
#define PG8_MMA(ai, bj, At, Bt) do { __builtin_amdgcn_s_setprio(1); _Pragma("unroll") for (int m = 0; m < 4; ++m) _Pragma("unroll") for (int n = 0; n < 2; ++n) _Pragma("unroll") for (int k = 0; k < 2; ++k) \
        acc[ai][bj][m][n] = __builtin_amdgcn_mfma_f32_16x16x32_bf16(Bt[n][k], At[m][k], acc[ai][bj][m][n], 0, 0, 0); __builtin_amdgcn_s_setprio(0); } while (0)
#define PG8_WAIT_V(n) asm volatile("s_waitcnt vmcnt(" #n ")" ::: "memory")
#define PG8_WAIT_L(n) asm volatile("s_waitcnt lgkmcnt(" #n ")" ::: "memory")
#define PG8_BAR __builtin_amdgcn_s_barrier()
#define PG8_SCHED __builtin_amdgcn_sched_barrier(0)
    Unit cur, nxt; int ui = 0;
    if (!S.next(0, cur)) return;
    f32x4 acc[2][2][4][2];
#pragma unroll
    for (int a = 0; a < 2; ++a)
#pragma unroll
        for (int b = 0; b < 2; ++b)
#pragma unroll
            for (int m = 0; m < 4; ++m)
#pragma unroll
                for (int n = 0; n < 2; ++n) acc[a][b][m][n] = (f32x4){0.f, 0.f, 0.f, 0.f};
    bf16x8 At[4][2], B0[2][2], B1[2][2];
    const char* cA = (const char*)g.A + (size_t)cur.pm * tstep; const char* cB = (const char*)g.Bt + (size_t)cur.pn * tstep;
    S.a_ready(cur);
    if constexpr (SP2) {
        PG8_STAGE(PG8_SB(0, 0), cB, voffB); PG8_STAGE(PG8_SB(0, 1), cB + hstep, voffB); PG8_STAGE(PG8_SA(0, 0), cA, voffA); PG8_STAGE(PG8_SA(0, 1), cA + hstep, voffA);
        if (wr == 1) PG8_BAR;
        PG8_WAIT_V(2); PG8_BAR;
        PG8_STAGE(PG8_SB(1, 0), cB + kstep, voffB); PG8_STAGE(PG8_SA(1, 0), cA + kstep, voffA); PG8_STAGE(PG8_SB(1, 1), cB + hstep + kstep, voffB);
        PG8_WAIT_V(6); PG8_BAR;
    } else {
        PG8_STAGE(PG8_SB(0, 0), cB, voffB); PG8_STAGE(PG8_SA(0, 0), cA, voffA); PG8_STAGE(PG8_SB(0, 1), cB + hstep, voffB); PG8_STAGE(PG8_SA(0, 1), cA + hstep, voffA);
        if (wr == 1) PG8_BAR;
        PG8_WAIT_V(4); PG8_BAR;
        PG8_STAGE(PG8_SB(1, 0), cB + kstep, voffB); PG8_STAGE(PG8_SA(1, 0), cA + kstep, voffA); PG8_STAGE(PG8_SB(1, 1), cB + hstep + kstep, voffB);
        PG8_WAIT_V(6); PG8_BAR;
    }
    for (;;) {
        const bool has_next = S.next(ui + 1, nxt);
        const char* nA = has_next ? (const char*)g.A + (size_t)nxt.pm * tstep : cA; const char* nB = has_next ? (const char*)g.Bt + (size_t)nxt.pn * tstep : cB;
        for (int t = 0; t < nt; t += 2) {
            const bool last = (t == nt - 2);
            const char* a1 = cA + (size_t)(t + 1) * kstep;
            const char* a2 = last ? nA : cA + (size_t)(t + 2) * kstep; const char* b2 = last ? nB : cB + (size_t)(t + 2) * kstep;
            const char* a3 = a2 + kstep; const char* b3 = b2 + kstep;
            if (last && has_next) S.a_ready(nxt);
            if constexpr (SP2) {
            PG8_LDB(B0, 0, 0); PG8_LDB(B1, 0, 1); PG8_SCHED; PG8_LDA(At, 0, 0); PG8_STAGE(PG8_SA(1, 1), a1 + hstep, voffA);
            PG8_WAIT_V(8); PG8_WAIT_L(0); PG8_BAR; PG8_MMA(0, 0, At, B0); PG8_MMA(0, 1, At, B1); PG8_BAR; PG8_SCHED;
            PG8_LDA(At, 0, 1); PG8_STAGE(PG8_SB(0, 0), b2, voffB); PG8_STAGE(PG8_SB(0, 1), b2 + hstep, voffB); PG8_STAGE(PG8_SA(0, 0), a2, voffA);
            PG8_WAIT_V(8); PG8_WAIT_L(0); PG8_BAR; PG8_MMA(1, 0, At, B0); PG8_MMA(1, 1, At, B1); PG8_BAR; PG8_SCHED;
            PG8_LDB(B0, 1, 0); PG8_LDB(B1, 1, 1); PG8_SCHED; PG8_LDA(At, 1, 0); PG8_STAGE(PG8_SA(0, 1), a2 + hstep, voffA);
            PG8_WAIT_V(8); PG8_WAIT_L(0); PG8_BAR; PG8_MMA(0, 0, At, B0); PG8_MMA(0, 1, At, B1); PG8_BAR; PG8_SCHED;
            PG8_LDA(At, 1, 1); PG8_STAGE(PG8_SB(1, 0), b3, voffB); PG8_STAGE(PG8_SB(1, 1), b3 + hstep, voffB); PG8_STAGE(PG8_SA(1, 0), a3, voffA);
            PG8_WAIT_V(8); PG8_WAIT_L(0); PG8_BAR; PG8_MMA(1, 0, At, B0); PG8_MMA(1, 1, At, B1); PG8_BAR; PG8_SCHED;
            } else {
            PG8_LDB(B0, 0, 0); PG8_SCHED; PG8_LDA(At, 0, 0); PG8_STAGE(PG8_SA(1, 1), a1 + hstep, voffA);
            PG8_WAIT_L(8); PG8_BAR; PG8_WAIT_L(0); PG8_MMA(0, 0, At, B0); PG8_BAR; PG8_SCHED;
            PG8_LDB(B1, 0, 1); PG8_STAGE(PG8_SB(0, 0), b2, voffB);
            PG8_BAR; PG8_WAIT_L(0); PG8_MMA(0, 1, At, B1); PG8_BAR;
            PG8_LDA(At, 0, 1); PG8_STAGE(PG8_SA(0, 0), a2, voffA);
            PG8_BAR; PG8_WAIT_L(0); PG8_MMA(1, 0, At, B0); PG8_BAR; PG8_SCHED;
            PG8_STAGE(PG8_SB(0, 1), b2 + hstep, voffB);
            PG8_WAIT_V(6); PG8_BAR; PG8_MMA(1, 1, At, B1); PG8_BAR;
            PG8_LDB(B0, 1, 0); PG8_SCHED; PG8_LDA(At, 1, 0); PG8_STAGE(PG8_SA(0, 1), a2 + hstep, voffA);
            PG8_WAIT_L(8); PG8_BAR; PG8_WAIT_L(0); PG8_MMA(0, 0, At, B0); PG8_BAR; PG8_SCHED;
            PG8_LDB(B1, 1, 1); PG8_STAGE(PG8_SB(1, 0), b3, voffB);
            PG8_BAR; PG8_WAIT_L(0); PG8_MMA(0, 1, At, B1); PG8_BAR;
            PG8_LDA(At, 1, 1); PG8_STAGE(PG8_SA(1, 0), a3, voffA);
            PG8_BAR; PG8_WAIT_L(0); PG8_MMA(1, 0, At, B0); PG8_BAR; PG8_SCHED;
            PG8_STAGE(PG8_SB(1, 1), b3 + hstep, voffB);
            PG8_WAIT_V(6); PG8_BAR; PG8_MMA(1, 1, At, B1); PG8_BAR;
            }
        }
        if constexpr (ALIGN_EPI) { if (wr == 0) PG8_BAR; }
        if constexpr (!Epi::AFTER_DRAIN) { E(acc, cur, wr, wc, fr, fq); S.done(cur); }
        if (!has_next) break;
#pragma unroll
        for (int a = 0; a < 2; ++a)
#pragma unroll
            for (int b = 0; b < 2; ++b)
#pragma unroll
                for (int m = 0; m < 4; ++m)
#pragma unroll
                    for (int n = 0; n < 2; ++n) acc[a][b][m][n] = (f32x4){0.f, 0.f, 0.f, 0.f};
        cur = nxt; cA = nA; cB = nB; ++ui;
        if constexpr (ALIGN_EPI) { if (wr == 1) PG8_BAR; }
    }
    PG8_WAIT_V(0);
    if constexpr (!ALIGN_EPI) { if (wr == 0) PG8_BAR; }
    PG8_BAR;
    if constexpr (Epi::AFTER_DRAIN) { E.fused(acc, cur, wr, wc, fr, fq, lds, wid, lane); S.done(cur); }
#undef PG8_SA
#undef PG8_SB
#undef PG8_STAGE
#undef PG8_LDA
#undef PG8_LDB
#undef PG8_MMA
#undef PG8_WAIT_V
#undef PG8_WAIT_L
#undef PG8_BAR
#undef PG8_SCHED
}
}
#define GAS __attribute__((address_space(1)))
#define LAS __attribute__((address_space(3)))
typedef unsigned short bf16;
typedef unsigned v4u __attribute__((ext_vector_type(4)));
typedef float f32x4 __attribute__((ext_vector_type(4)));
typedef short bf16x8 __attribute__((ext_vector_type(8)));
typedef GAS unsigned gu32;
typedef GAS unsigned long long gu64;
#define RLX_AGENT __ATOMIC_RELAXED, __HIP_MEMORY_SCOPE_AGENT
#define LDS_WAIT() asm volatile("s_waitcnt lgkmcnt(0)" ::: "memory")
#define VM_WAIT() asm volatile("s_waitcnt vmcnt(0)" ::: "memory")
__device__ __forceinline__ unsigned long long rt() { return __builtin_amdgcn_s_memrealtime(); }
__device__ __forceinline__ unsigned f2bf(float f) { unsigned u = __builtin_bit_cast(unsigned, f); return (u + 0x7fffu + ((u >> 16) & 1u)) >> 16; }
__device__ __forceinline__ unsigned pk2(float lo, float hi) { return f2bf(lo) | (f2bf(hi) << 16); }

#define XB_TMO      128
#define XB_XCNT(j)  (256  + 64 * (j))
#define XB_XSUB(j)  (1280 + 64 * (j))
#define XB_XGEN(j)  (2304 + 64 * (j))
#define XB_TOP      3328
#define XB_TOPGEN   3392
#define XCD_BAR_WORDS 3456
#define XB_SPIN_CAP (1u << 18)

__device__ __forceinline__ unsigned xb_ld(unsigned* p)              { return __hip_atomic_load(p, __ATOMIC_RELAXED, __HIP_MEMORY_SCOPE_AGENT); }
__device__ __forceinline__ unsigned xb_add(unsigned* p, unsigned v) { return __hip_atomic_fetch_add(p, v, __ATOMIC_RELAXED, __HIP_MEMORY_SCOPE_AGENT); }
__device__ __forceinline__ unsigned xb_xcc_id() { return (unsigned)__builtin_amdgcn_s_getreg((3 << 11) | 20) & 0xFu; }
#define XB_SPIN(cond, bar) do { unsigned _sp = 0; while (cond) { __builtin_amdgcn_s_sleep(1); \
    if ((++_sp & 255u) == 0u) { if (xb_ld(&(bar)[XB_TMO])) break; if (_sp > XB_SPIN_CAP) { atomicAdd(&(bar)[XB_TMO], 1u); break; } } } } while (0)

struct XcdBarrier {
    unsigned* bar; unsigned x;
    volatile LAS unsigned* st;
};

__device__ __forceinline__ XcdBarrier xcd_barrier_post(unsigned* bar, volatile LAS unsigned* st) {
    XcdBarrier b; b.bar = bar; b.x = xb_xcc_id(); b.st = st;
    if (threadIdx.x == 0) (void)xb_add(&bar[XB_XCNT(b.x)], 1u);
    return b;
}
__device__ __forceinline__ void xcd_barrier_complete(unsigned* bar, unsigned x, unsigned& nloc, unsigned& nx) {
    const unsigned G = gridDim.x * gridDim.y * gridDim.z;
    unsigned sum, cnt, mine, sp = 0u;
    for (;;) {
        sum = 0u; cnt = 0u; mine = 0u;
#pragma unroll
        for (unsigned j = 0; j < 16; ++j) { const unsigned c = xb_ld(&bar[XB_XCNT(j)]); sum += c; cnt += (c > 0u) ? 1u : 0u; mine = (j == x) ? c : mine; }
        if (sum == G) break;
        __builtin_amdgcn_s_sleep(1);
        if ((++sp & 255u) == 0u) { if (xb_ld(&bar[XB_TMO])) break; if (sp > XB_SPIN_CAP) { atomicAdd(&bar[XB_TMO], 1u); break; } }
    }
    nloc = mine > 0u ? mine : 1u; nx = cnt > 0u ? cnt : 1u;
}

__device__ __forceinline__ void xcd_barrier(const XcdBarrier& b) {
    asm volatile("s_waitcnt vmcnt(0)" ::: "memory");
    __syncthreads();
    if (threadIdx.x == 0) {
        unsigned* bar = b.bar;
        __builtin_amdgcn_s_waitcnt(0);
        unsigned nloc = b.st[0], nx = b.st[1];
        if (nloc == 0u) { xcd_barrier_complete(bar, b.x, nloc, nx); b.st[0] = nloc; b.st[1] = nx; }
        const unsigned old = xb_add(&bar[XB_XSUB(b.x)], 1u);
        const unsigned gen = old / nloc;
        if (old + 1u == (gen + 1u) * nloc) {
            __builtin_amdgcn_fence(__ATOMIC_RELEASE, "agent");
            asm volatile("s_waitcnt vmcnt(0)" ::: "memory");
            const unsigned og = xb_add(&bar[XB_TOP], 1u);
            const unsigned tg = og / nx;
            if (og + 1u == (tg + 1u) * nx) xb_add(&bar[XB_TOPGEN], 1u);
            else XB_SPIN(xb_ld(&bar[XB_TOPGEN]) == tg, bar);
            __builtin_amdgcn_fence(__ATOMIC_ACQUIRE, "agent");
            xb_add(&bar[XB_XGEN(b.x)], 1u);
            asm volatile("s_waitcnt vmcnt(0)" ::: "memory");
        } else {
            XB_SPIN(xb_ld(&bar[XB_XGEN(b.x)]) == gen, bar);
            __builtin_amdgcn_fence(__ATOMIC_ACQUIRE, "agent");
            asm volatile("s_waitcnt vmcnt(0)" ::: "memory");
        }
    }
    __syncthreads();
}

constexpr int S = 8192, DM = 2048, HD = 64, NH = 16;
constexpr int NIN = 8704, NEXP = 32, DEXP = 512, NMOD = 12288;
constexpr float RMS_EPS = 1e-6f;
constexpr float LOG2E = 1.4426950408889634f;
constexpr float C2 = 0.125f * LOG2E;
constexpr int NWAVES = 8, NTHREADS = 512;
constexpr int PER_PHASE = 12;
constexpr int N_LAUNCHES = MK_N_LAUNCHES;

constexpr size_t MiB = 1u << 20;
constexpr size_t WS_CTL = 0, CTL_ZERO_BYTES = 1 * MiB;
constexpr size_t WS_MODP = 1 * MiB;
constexpr size_t WS_MOD = WS_MODP + 1536 * 1024;
constexpr size_t WS_KMEAN = WS_MOD + 64 * 1024;
constexpr size_t WS_WRT = WS_KMEAN + 128 * 1024;
constexpr size_t WS_SSQ = WS_WRT + 288 * 1024;
constexpr size_t WS_EW = WS_SSQ + MiB;
constexpr size_t WS_LIST = WS_EW + 64 * 1024;
constexpr size_t WS_DESC = WS_LIST + MiB;
constexpr size_t WS_SMALL_END = WS_DESC + 192 * 1024;
static_assert(WS_SMALL_END <= 6 * MiB, "small region");
constexpr size_t WS_WT_OAB = 6 * MiB;
constexpr size_t WS_WT_OUT = 14 * MiB;
constexpr size_t WS_WT_IN = 22 * MiB;
constexpr size_t WS_WT_GU = 56 * MiB;
constexpr size_t WS_WT_D = 184 * MiB;
constexpr size_t WS_XN = 248 * MiB;
constexpr size_t WS_QA = 280 * MiB, WS_KA = 296 * MiB, WS_VA = 312 * MiB, WS_QB = 328 * MiB, WS_KB = 344 * MiB, WS_VB = 348 * MiB;
constexpr size_t WS_SGA = 352 * MiB, WS_SGB = 384 * MiB;
constexpr size_t WS_Y1 = 416 * MiB;
constexpr size_t WS_Y = 448 * MiB;
constexpr size_t WS_TMPA = 512 * MiB;
constexpr size_t WS_OAB = 576 * MiB;
constexpr size_t WS_END = 608 * MiB;
constexpr size_t WS_YE = 280 * MiB;
constexpr size_t WS_ACT = 416 * MiB;
constexpr size_t WS_XG = 448 * MiB;
constexpr int MAXROWS = 24576;
static_assert(WS_XG + (size_t)MAXROWS * DM * 2 <= WS_OAB && WS_YE + (size_t)S * 2 * DM * 4 <= WS_Y1, "overlays");
constexpr int CW_TMO = 0, CW_CODE = 1, CW_BAR = 4096, CW_CNT = 8192;

constexpr int RING_OFF = 0, RING_BYTES = 131072;
constexpr int LDSCTL_OFF = RING_BYTES;
constexpr int LDS_BYTES = 147456;

typedef unsigned u32x4_t __attribute__((ext_vector_type(4)));
typedef float f32x2_t __attribute__((ext_vector_type(2)));

__device__ __forceinline__ float bf2f(unsigned short b) { return __uint_as_float(((unsigned)b) << 16); }
__device__ __forceinline__ float bflo(unsigned w) { return __uint_as_float(w << 16); }
__device__ __forceinline__ float bfhi(unsigned w) { return __uint_as_float(w & 0xffff0000u); }
__device__ __forceinline__ float wave_sum(float v) {
#pragma unroll
    for (int o = 1; o < 64; o <<= 1) v += __shfl_xor(v, o);
    return v;
}
__device__ __forceinline__ float wave_max(float v) {
#pragma unroll
    for (int o = 1; o < 64; o <<= 1) v = fmaxf(v, __shfl_xor(v, o));
    return v;
}
__device__ __forceinline__ float sigmoidf_(float v) { return __builtin_amdgcn_rcpf(1.0f + __builtin_amdgcn_exp2f(-v * LOG2E)); }

struct Ctx {
    const float* in[20]; float* out; unsigned char* ws;
    int tid, lane, wave, G, vcu;
    LAS unsigned char* lds;
};
enum { I_X = 0, I_C, I_WADA, I_BADA, I_GPRE, I_GPOST, I_WIN, I_SINKS, I_WOA, I_WOB, I_WOUT, I_GPREF, I_GPOSTF, I_WRG, I_BRG, I_WRE, I_BRE, I_WG, I_WU, I_WD };

__device__ __forceinline__ void tr_item(const float* W, int N, bf16* WT, int ldt, int wt_row0, int k0, int n0, LAS float* scr, int lane) {
#pragma unroll 8
    for (int i = 0; i < 32; ++i) { const int kk = 2 * i + (lane >> 5); scr[kk * 33 + (lane & 31)] = W[(size_t)(k0 + kk) * N + n0 + (lane & 31)]; }
    LDS_WAIT(); asm volatile("" ::: "memory");
    const int c = lane & 7;
#pragma unroll
    for (int j = 0; j < 4; ++j) { const int n = (lane >> 3) + 8 * j; const LAS float* s = scr + (8 * c) * 33 + n;
        v4u o; o.x = pk2(s[0 * 33], s[1 * 33]); o.y = pk2(s[2 * 33], s[3 * 33]); o.z = pk2(s[4 * 33], s[5 * 33]); o.w = pk2(s[6 * 33], s[7 * 33]);
        *(GAS v4u*)(WT + (size_t)(wt_row0 + n) * ldt + k0 + 8 * c) = o; }
    LDS_WAIT(); asm volatile("" ::: "memory");
}
__device__ __forceinline__ void phase0(Ctx& F) {
    LAS float* scr = (LAS float*)(F.lds + RING_OFF + F.wave * 16384);
    const int gw = F.vcu * NWAVES + F.wave, NGW = F.G * NWAVES, lane = F.lane;
    constexpr int I_GEMV = 32 * 48, I_RT = 36;
    constexpr int I_IN = 32 * 272, I_OA = 16 * 64, I_OUT = 32 * 64, I_E = 32 * 512;
    constexpr int NITEMS = I_GEMV + I_RT + I_IN + 2 * I_OA + I_OUT + 3 * I_E;
    bf16* WT_OAB = (bf16*)(F.ws + WS_WT_OAB); bf16* WT_OUT = (bf16*)(F.ws + WS_WT_OUT); bf16* WT_IN = (bf16*)(F.ws + WS_WT_IN);
    bf16* WT_GU = (bf16*)(F.ws + WS_WT_GU); bf16* WT_D = (bf16*)(F.ws + WS_WT_D);
    for (int it = gw; it < NITEMS; it += NGW) {
        int r = it;
        if (r < I_GEMV) {
            const int kc = r / 48, span = r % 48;
            const float cv = F.in[I_C][64 * kc + lane];
            const float sv = cv / (1.0f + expf(-cv));
            f32x4 acc = {0.f, 0.f, 0.f, 0.f};
            const float* wp = F.in[I_WADA] + (size_t)(64 * kc) * NMOD + 256 * span + 4 * lane;
#pragma unroll 8
            for (int rr = 0; rr < 64; ++rr) { const f32x4 w = *(const GAS f32x4*)(wp + (size_t)rr * NMOD); const float s = __shfl(sv, rr); acc += w * s; }
            *(GAS f32x4*)((float*)(F.ws + WS_MODP) + (size_t)kc * NMOD + 256 * span + 4 * lane) = acc;
            continue;
        }
        r -= I_GEMV;
        if (r < I_RT) {
            float* wrt = (float*)(F.ws + WS_WRT) + (size_t)r * DM;
            for (int d = lane; d < DM; d += 64) wrt[d] = (r < 4) ? F.in[I_WRG][d * 4 + r] : F.in[I_WRE][d * 32 + (r - 4)];
            continue;
        }
        r -= I_RT;
        if (r < I_IN) { const int kb = r / 272, nb = r % 272; tr_item(F.in[I_WIN], NIN, WT_IN, DM, 32 * nb, 64 * kb, 32 * nb, scr, lane); continue; }
        r -= I_IN;
        if (r < I_OA) { const int kb = r / 64, nb = r % 64; tr_item(F.in[I_WOA], DM, WT_OAB, 1024, 32 * nb, 64 * kb, 32 * nb, scr, lane); continue; }
        r -= I_OA;
        if (r < I_OA) { const int kb = r / 64, nb = r % 64; tr_item(F.in[I_WOB], DM, WT_OAB + (size_t)DM * 1024, 1024, 32 * nb, 64 * kb, 32 * nb, scr, lane); continue; }
        r -= I_OA;
        if (r < I_OUT) { const int kb = r / 64, nb = r % 64; tr_item(F.in[I_WOUT], DM, WT_OUT, DM, 32 * nb, 64 * kb, 32 * nb, scr, lane); continue; }
        r -= I_OUT;
        if (r < I_E) { const int e = r / 512, rr = r % 512, kb = rr / 16, nb = rr % 16, n0 = 32 * nb;
            tr_item(F.in[I_WG] + (size_t)e * DM * DEXP, DEXP, WT_GU, DM, e * 1024 + 256 * (n0 >> 7) + (n0 & 127), 64 * kb, n0, scr, lane); continue; }
        r -= I_E;
        if (r < I_E) { const int e = r / 512, rr = r % 512, kb = rr / 16, nb = rr % 16, n0 = 32 * nb;
            tr_item(F.in[I_WU] + (size_t)e * DM * DEXP, DEXP, WT_GU, DM, e * 1024 + 256 * (n0 >> 7) + 128 + (n0 & 127), 64 * kb, n0, scr, lane); continue; }
        r -= I_E;
        { const int e = r / 512, rr = r % 512, kb = rr / 64, nb = rr % 64;
            tr_item(F.in[I_WD] + (size_t)e * DEXP * DM, DM, WT_D, DEXP, e * 2048 + 32 * nb, 64 * kb, 32 * nb, scr, lane); }
    }
}

__device__ __forceinline__ float mod_value(const Ctx& F, int n) {
    const float* mp = (const float*)(F.ws + WS_MODP) + n;
    float s = F.in[I_BADA][n];
#pragma unroll 8
    for (int kc = 0; kc < 32; ++kc) s += mp[(size_t)kc * NMOD];
    return s;
}
__device__ __forceinline__ void phase1(Ctx& F) {
    LAS float* gs = (LAS float*)(F.lds + RING_OFF);
    LAS float* sh = gs + DM;
    for (int n = F.tid; n < DM; n += NTHREADS) { const float shv = mod_value(F, n), scv = mod_value(F, DM + n); gs[n] = F.in[I_GPRE][n] * (1.0f + scv); sh[n] = shv; }
    { const int per = NMOD / F.G + 1; const int n = blockIdx.x * per + F.tid; if (F.tid < per && n < NMOD) ((float*)(F.ws + WS_MOD))[n] = mod_value(F, n); }
    __syncthreads();
    const int gw = F.vcu * NWAVES + F.wave, NGW = F.G * NWAVES, lane = F.lane;
    bf16* XN = (bf16*)(F.ws + WS_XN);
    for (int m = gw; m < S; m += NGW) {
        const GAS f32x4* xr = (const GAS f32x4*)(F.in[I_X] + (size_t)m * DM) + lane;
        f32x4 v[8]; float s2 = 0.f;
#pragma unroll
        for (int j = 0; j < 8; ++j) { v[j] = xr[64 * j]; s2 += (v[j].x * v[j].x + v[j].y * v[j].y) + (v[j].z * v[j].z + v[j].w * v[j].w); }
        const float rstd = 1.0f / sqrtf(wave_sum(s2) * (1.0f / DM) + RMS_EPS);
        GAS unsigned long long* o8 = (GAS unsigned long long*)(XN + (size_t)m * DM) + lane;
#pragma unroll
        for (int j = 0; j < 8; ++j) { const int d = 4 * lane + 256 * j; const f32x4 g4 = *(const LAS f32x4*)(gs + d), s4 = *(const LAS f32x4*)(sh + d);
            const f32x4 h = v[j] * rstd * g4 + s4;
            o8[64 * j] = (unsigned long long)pk2(h.x, h.y) | ((unsigned long long)pk2(h.z, h.w) << 32); }
    }
    __syncthreads();
}

template <class Epi, class Sched>
__device__ __forceinline__ void gemm_naive(const pg8::Gemm g, const Sched& Sc, const Epi& E) {
    using namespace pg8;
    const int tid = threadIdx.x, wid = __builtin_amdgcn_readfirstlane(tid >> 6), lane = tid & 63, wr = wid >> 2, wc = wid & 3, fr = lane & 15, fq = lane >> 4;
    const int K = g.K;
    Unit u;
    for (int i = 0; Sc.next(i, u); ++i) {
        pg8::f32x4 acc[2][2][4][2];
#pragma unroll
        for (int a = 0; a < 2; ++a)
#pragma unroll
            for (int b = 0; b < 2; ++b)
#pragma unroll
                for (int m = 0; m < 4; ++m)
#pragma unroll
                    for (int n = 0; n < 2; ++n) acc[a][b][m][n] = (pg8::f32x4){0.f, 0.f, 0.f, 0.f};
        const bf16_t* Ab = g.A + (size_t)u.pm * 256 * K; const bf16_t* Bb = g.Bt + (size_t)u.pn * 256 * K;
        const bf16_t* Ap = Ab + (size_t)(64 * wr + fr) * K + 8 * fq;
        const bf16_t* Bp = Bb + (size_t)(32 * wc) * K + 8 * fq;
        const int c0 = Epi::PERM ? perm32(fr) : fr, c1 = Epi::PERM ? perm32(16 + fr) : 16 + fr;
#pragma unroll 1
        for (int k0 = 0; k0 < K; k0 += 32) {
            pg8::bf16x8 b[2][2];
#pragma unroll
            for (int bj = 0; bj < 2; ++bj) { b[bj][0] = *(const pg8::bf16x8*)(Bp + (size_t)(128 * bj + c0) * K + k0); b[bj][1] = *(const pg8::bf16x8*)(Bp + (size_t)(128 * bj + c1) * K + k0); }
#pragma unroll
            for (int ai = 0; ai < 2; ++ai) {
                pg8::bf16x8 a[4];
#pragma unroll
                for (int m = 0; m < 4; ++m) a[m] = *(const pg8::bf16x8*)(Ap + (size_t)(128 * ai + 16 * m) * K + k0);
#pragma unroll
                for (int bj = 0; bj < 2; ++bj)
#pragma unroll
                    for (int m = 0; m < 4; ++m)
#pragma unroll
                        for (int n = 0; n < 2; ++n) acc[ai][bj][m][n] = __builtin_amdgcn_mfma_f32_16x16x32_bf16(b[bj][n], a[m], acc[ai][bj][m][n], 0, 0, 0);
                asm volatile("" ::: "memory");
            }
        }
        E(acc, u, wr, wc, fr, fq);
    }
}
template <class Epi, class Sched>
__device__ __forceinline__ void run_gemm(Ctx& F, const pg8::Gemm g, const Sched& Sc, const Epi& E) {
#if FAST_GEMM
    pg8::gemm_phase<Epi, Sched, true, true>((PG8_LAS unsigned char*)(F.lds + RING_OFF), g, Sc, E);
#else
    gemm_naive<Epi, Sched>(g, Sc, E);
#endif
}

typedef pg8::f32x4 acc_t[2][2][4][2];
struct EpiQKVG {
    static constexpr bool PERM = true, AFTER_DRAIN = false;
    unsigned char* ws;
    __device__ __forceinline__ void operator()(const acc_t& acc, const pg8::Unit& u, int wr, int wc, int fr, int fq) const {
        const int pn = u.pn; bf16* base; int ldc, colt; float sc = 1.0f; bool sig = false;
        if (pn < 4) { base = (bf16*)(ws + WS_QA); ldc = 1024; colt = 256 * pn; sc = C2; }
        else if (pn < 8) { base = (bf16*)(ws + WS_KA); ldc = 1024; colt = 256 * (pn - 4); }
        else if (pn < 12) { base = (bf16*)(ws + WS_VA); ldc = 1024; colt = 256 * (pn - 8); }
        else if (pn < 16) { base = (bf16*)(ws + WS_QB); ldc = 1024; colt = 256 * (pn - 12); sc = C2; }
        else if (pn == 16) { base = (bf16*)(ws + WS_KB); ldc = 256; colt = 0; }
        else if (pn == 17) { base = (bf16*)(ws + WS_VB); ldc = 256; colt = 0; }
        else if (pn < 26) { base = (bf16*)(ws + WS_SGA); ldc = 2048; colt = 256 * (pn - 18); sig = true; }
        else { base = (bf16*)(ws + WS_SGB); ldc = 2048; colt = 256 * (pn - 26); sig = true; }
        const int row0 = u.pm * 256 + wr * 64 + fr, col0 = colt + wc * 32 + 8 * fq;
#pragma unroll
        for (int ai = 0; ai < 2; ++ai)
#pragma unroll
            for (int m = 0; m < 4; ++m) { bf16* rowp = base + (size_t)(row0 + ai * 128 + m * 16) * ldc + col0;
#pragma unroll
                for (int bj = 0; bj < 2; ++bj) { pg8::f32x4 v0 = acc[ai][bj][m][0], v1 = acc[ai][bj][m][1];
                    if (sig) { v0 = (pg8::f32x4){sigmoidf_(v0[0]), sigmoidf_(v0[1]), sigmoidf_(v0[2]), sigmoidf_(v0[3])}; v1 = (pg8::f32x4){sigmoidf_(v1[0]), sigmoidf_(v1[1]), sigmoidf_(v1[2]), sigmoidf_(v1[3])}; }
                    else { v0 = v0 * sc; v1 = v1 * sc; }
                    pg8::u32x4 w; w.x = pg8::cvt_pk_bf16(v0[0], v0[1]); w.y = pg8::cvt_pk_bf16(v0[2], v0[3]); w.z = pg8::cvt_pk_bf16(v1[0], v1[1]); w.w = pg8::cvt_pk_bf16(v1[2], v1[3]);
                    *(pg8::u32x4*)(rowp + bj * 128) = w; } }
    }
};
struct EpiGate {
    static constexpr bool PERM = true, AFTER_DRAIN = false;
    unsigned char* ws;
    __device__ __forceinline__ void operator()(const acc_t& acc, const pg8::Unit& u, int wr, int wc, int fr, int fq) const {
        const int which = u.pm >> 5, pm = u.pm & 31, pn = u.pn & 7;
        const bf16* SG = (const bf16*)(ws + (which ? WS_SGB : WS_SGA)); float* T = (float*)(ws + WS_TMPA); bf16* Y1 = (bf16*)(ws + WS_Y1);
        const int row0 = pm * 256 + wr * 64 + fr, col0 = pn * 256 + wc * 32 + 8 * fq;
#pragma unroll
        for (int ai = 0; ai < 2; ++ai)
#pragma unroll
            for (int m = 0; m < 4; ++m)
#pragma unroll
                for (int bj = 0; bj < 2; ++bj) { const size_t off = (size_t)(row0 + ai * 128 + m * 16) * DM + col0 + bj * 128;
                    const pg8::u32x4 sg = *(const pg8::u32x4*)(SG + off);
                    pg8::f32x4 v0 = acc[ai][bj][m][0], v1 = acc[ai][bj][m][1];
                    v0[0] *= bflo(sg.x); v0[1] *= bfhi(sg.x); v0[2] *= bflo(sg.y); v0[3] *= bfhi(sg.y);
                    v1[0] *= bflo(sg.z); v1[1] *= bfhi(sg.z); v1[2] *= bflo(sg.w); v1[3] *= bfhi(sg.w);
                    if (which == 0) { *(pg8::f32x4*)(T + off) = v0; *(pg8::f32x4*)(T + off + 4) = v1; }
                    else { const pg8::f32x4 t0 = *(const pg8::f32x4*)(T + off), t1 = *(const pg8::f32x4*)(T + off + 4); v0 += t0; v1 += t1;
                        pg8::u32x4 w; w.x = pg8::cvt_pk_bf16(v0[0], v0[1]); w.y = pg8::cvt_pk_bf16(v0[2], v0[3]); w.z = pg8::cvt_pk_bf16(v1[0], v1[1]); w.w = pg8::cvt_pk_bf16(v1[2], v1[3]);
                        *(pg8::u32x4*)(Y1 + off) = w; } }
    }
};
struct EpiY {
    static constexpr bool PERM = false, AFTER_DRAIN = false;
    unsigned char* ws;
    __device__ __forceinline__ void operator()(const acc_t& acc, const pg8::Unit& u, int wr, int wc, int fr, int fq) const {
        float* Y = (float*)(ws + WS_Y); float* SSQ = (float*)(ws + WS_SSQ);
        const int row0 = u.pm * 256 + wr * 64 + fr, col0 = u.pn * 256 + wc * 32 + 4 * fq;
#pragma unroll
        for (int ai = 0; ai < 2; ++ai)
#pragma unroll
            for (int m = 0; m < 4; ++m) { const int row = row0 + ai * 128 + m * 16; float ss = 0.f;
#pragma unroll
                for (int bj = 0; bj < 2; ++bj)
#pragma unroll
                    for (int n = 0; n < 2; ++n) { const pg8::f32x4 v = acc[ai][bj][m][n]; *(pg8::f32x4*)(Y + (size_t)row * DM + col0 + bj * 128 + n * 16) = v;
                        ss += (v[0] * v[0] + v[1] * v[1]) + (v[2] * v[2] + v[3] * v[3]); }
                ss += __shfl_xor(ss, 16); ss += __shfl_xor(ss, 32);
                if (fq == 0) SSQ[(size_t)row * 32 + u.pn * 4 + wc] = ss; }
    }
};
struct EpiGU {
    static constexpr bool PERM = true, AFTER_DRAIN = false;
    unsigned char* ws;
    __device__ __forceinline__ void operator()(const acc_t& acc, const pg8::Unit& u, int wr, int wc, int fr, int fq) const {
        bf16* ACT = (bf16*)(ws + WS_ACT);
        const int row0 = u.pm * 256 + wr * 64 + fr, col0 = (u.pn & 3) * 128 + wc * 32 + 8 * fq;
#pragma unroll
        for (int ai = 0; ai < 2; ++ai)
#pragma unroll
            for (int m = 0; m < 4; ++m) { float a[8];
#pragma unroll
                for (int n = 0; n < 2; ++n)
#pragma unroll
                    for (int i = 0; i < 4; ++i) { const float gv = acc[ai][0][m][n][i], uv = acc[ai][1][m][n][i]; a[4 * n + i] = gv * sigmoidf_(gv) * uv; }
                pg8::u32x4 w; w.x = pg8::cvt_pk_bf16(a[0], a[1]); w.y = pg8::cvt_pk_bf16(a[2], a[3]); w.z = pg8::cvt_pk_bf16(a[4], a[5]); w.w = pg8::cvt_pk_bf16(a[6], a[7]);
                *(pg8::u32x4*)(ACT + (size_t)(row0 + ai * 128 + m * 16) * DEXP + col0) = w; }
    }
};
struct EpiDown {
    static constexpr bool PERM = false, AFTER_DRAIN = false;
    unsigned char* ws;
    __device__ __forceinline__ void operator()(const acc_t& acc, const pg8::Unit& u, int wr, int wc, int fr, int fq) const {
        float* YE = (float*)(ws + WS_YE); const int2* DESC = (const int2*)(ws + WS_DESC);
        const int row0 = u.pm * 256 + wr * 64 + fr, col0 = (u.pn & 7) * 256 + wc * 32 + 4 * fq;
#pragma unroll
        for (int ai = 0; ai < 2; ++ai)
#pragma unroll
            for (int m = 0; m < 4; ++m) { const int2 d = DESC[row0 + ai * 128 + m * 16]; const float w = __int_as_float(d.y);
                if (d.x >= 0) {
#pragma unroll
                    for (int bj = 0; bj < 2; ++bj)
#pragma unroll
                        for (int n = 0; n < 2; ++n) *(pg8::f32x4*)(YE + (size_t)d.x * DM + col0 + bj * 128 + n * 16) = acc[ai][bj][m][n] * w; } }
    }
};

struct GateOrder {
    pg8::StaticOrder so;
    __device__ void init(int G, int c) { so.init(S, DM, G, c); }
    __device__ bool next(int i, pg8::Unit& u) const {
        const int rounds = (so.nwg + so.G - 1) / so.G;
        const int which = i & 1, ti = i >> 1; if (ti >= rounds) return false;
        pg8::Unit t; if (!so.next(ti, t)) return false;
        u.pm = t.pm + 32 * which; u.pn = t.pn + 8 * which; return true;
    }
    __device__ __forceinline__ void a_ready(const pg8::Unit&) const {}
    __device__ __forceinline__ void done(const pg8::Unit&) const {}
};
struct MoeOrder {
    const volatile LAS int* mts; int shift, G, v;
    __device__ bool next(int i, pg8::Unit& u) const {
        const int total = mts[32] << shift; const int L = i * G + v; if (L >= total) return false;
        const int mt = L >> shift, pn = L & ((1 << shift) - 1); int e = 0;
        for (int j = 1; j < 32; ++j) e += (mts[j] <= mt) ? 1 : 0;
        u.pm = mt; u.pn = (e << shift) | pn; return true;
    }
    __device__ __forceinline__ void a_ready(const pg8::Unit&) const {}
    __device__ __forceinline__ void done(const pg8::Unit&) const {}
};
__device__ __forceinline__ void build_mts(Ctx& F) {
    volatile LAS int* mts = (volatile LAS int*)(F.lds + LDSCTL_OFF) + 64;
    __syncthreads();
    if (F.tid == 0) { const gu32* cnt = (const gu32*)(F.ws + WS_CTL) + CW_CNT; int acc = 0;
        for (int e = 0; e < 32; ++e) { mts[e] = acc; const int c = (int)__hip_atomic_load(cnt + e, RLX_AGENT); acc += (c + 255) >> 8; }
        mts[32] = acc; }
    __syncthreads();
}

__device__ __forceinline__ void phase3(Ctx& F) {
    const int gw = F.vcu * NWAVES + F.wave, NGW = F.G * NWAVES, lane = F.lane;
    const bf16* KA = (const bf16*)(F.ws + WS_KA); float* KM = (float*)(F.ws + WS_KMEAN);
    for (int it = gw; it < 16 * 32; it += NGW) { const int h = it >> 5, j = it & 31; float s = 0.f;
        const bf16* p = KA + (size_t)(256 * j) * 1024 + 64 * h + lane;
#pragma unroll 8
        for (int r = 0; r < 256; ++r) s += bf2f(p[(size_t)r * 1024]);
        KM[(size_t)it * 64 + lane] = s * (1.0f / 256.0f); }
}

__device__ __forceinline__ void attn_naive(Ctx& F) {
    const int gw = F.vcu * NWAVES + F.wave, NGW = F.G * NWAVES, lane = F.lane;
    LAS float* wscr = (LAS float*)(F.lds + RING_OFF) + F.wave * 1280;
    LAS float* qs = wscr + 1024; LAS float* gsb = wscr + 1088;
    const bf16* QA = (const bf16*)(F.ws + WS_QA); const bf16* KA = (const bf16*)(F.ws + WS_KA); const bf16* VA = (const bf16*)(F.ws + WS_VA);
    const bf16* QB = (const bf16*)(F.ws + WS_QB); const bf16* KB = (const bf16*)(F.ws + WS_KB); const bf16* VB = (const bf16*)(F.ws + WS_VB);
    const float* KM = (const float*)(F.ws + WS_KMEAN);
    bf16* OA = (bf16*)(F.ws + WS_OAB); bf16* OB = OA + (size_t)S * 1024;
    const float NEG = -INFINITY;
    for (int it = gw; it < 2 * S * NH; it += NGW) {
        const int mode = it / (S * NH), rem = it % (S * NH), t = rem >> 4, h = rem & 15;
        const float slope2 = exp2f(-0.5f * (float)(h + 1)) * LOG2E;
        if (mode == 0) {
            const int blk = t >> 8;
            qs[lane] = bf2f(QA[(size_t)t * 1024 + 64 * h + lane]);
            LDS_WAIT(); asm volatile("" ::: "memory");
            float g = NEG;
            if (lane < blk) { g = 0.f; const float* kmp = KM + (size_t)(h * 32 + lane) * 64; for (int d = 0; d < 64; ++d) g += qs[d] * kmp[d]; }
            if (lane < 32) gsb[lane] = g;
            LDS_WAIT(); asm volatile("" ::: "memory");
            float b0 = NEG, b1 = NEG, b2 = NEG; int i0 = -1, i1 = -1, i2 = -1;
            for (int j = 0; j < blk; ++j) { const float v = gsb[j];
                if (v > b0) { b2 = b1; i2 = i1; b1 = b0; i1 = i0; b0 = v; i0 = j; }
                else if (v > b1) { b2 = b1; i2 = i1; b1 = v; i1 = j; }
                else if (v > b2) { b2 = v; i2 = j; } }
            float mx = NEG; int nk = 0;
            for (int seg = 0; seg < 4; ++seg) { const int bj = seg == 0 ? i0 : seg == 1 ? i1 : seg == 2 ? i2 : blk; if (bj < 0) continue;
                const int nkeys = (seg == 3) ? (t & 255) + 1 : 256;
                for (int k0 = 0; k0 < nkeys; k0 += 64) { const int key = k0 + lane;
                    if (key < nkeys) { const int kp = bj * 256 + key; const GAS v4u* kr = (const GAS v4u*)(KA + (size_t)kp * 1024 + 64 * h); float s = 0.f;
#pragma unroll
                        for (int d8 = 0; d8 < 8; ++d8) { const v4u kv = kr[d8]; const LAS float* q8 = qs + 8 * d8;
                            s += q8[0] * bflo(kv.x) + q8[1] * bfhi(kv.x) + q8[2] * bflo(kv.y) + q8[3] * bfhi(kv.y) + q8[4] * bflo(kv.z) + q8[5] * bfhi(kv.z) + q8[6] * bflo(kv.w) + q8[7] * bfhi(kv.w); }
                        s += slope2 * (float)(kp - t); wscr[nk + key] = s; mx = fmaxf(mx, s); } }
                nk += nkeys; }
            mx = wave_max(mx);
            LDS_WAIT(); asm volatile("" ::: "memory");
            float l = 0.f, o = 0.f; int idx = 0;
            for (int seg = 0; seg < 4; ++seg) { const int bj = seg == 0 ? i0 : seg == 1 ? i1 : seg == 2 ? i2 : blk; if (bj < 0) continue;
                const int nkeys = (seg == 3) ? (t & 255) + 1 : 256;
                const bf16* vr = VA + (size_t)(bj * 256) * 1024 + 64 * h + lane;
                for (int key = 0; key < nkeys; ++key) { const float p = exp2f(wscr[idx + key] - mx); l += p; o += p * bf2f(vr[(size_t)key * 1024]); }
                idx += nkeys; }
            OA[(size_t)t * 1024 + 64 * h + lane] = (bf16)f2bf(o / l);
            LDS_WAIT(); asm volatile("" ::: "memory");
        } else {
            const int hkv = h >> 2; const float sink2 = F.in[I_SINKS][h] * LOG2E;
            qs[lane] = bf2f(QB[(size_t)t * 1024 + 64 * h + lane]);
            LDS_WAIT(); asm volatile("" ::: "memory");
            const int kp0 = t - 127 > 0 ? t - 127 : 0, nkeys = t - kp0 + 1;
            float mx = NEG;
            for (int k0 = 0; k0 < nkeys; k0 += 64) { const int key = k0 + lane;
                if (key < nkeys) { const int kp = kp0 + key; const GAS v4u* kr = (const GAS v4u*)(KB + (size_t)kp * 256 + 64 * hkv); float s = 0.f;
#pragma unroll
                    for (int d8 = 0; d8 < 8; ++d8) { const v4u kv = kr[d8]; const LAS float* q8 = qs + 8 * d8;
                        s += q8[0] * bflo(kv.x) + q8[1] * bfhi(kv.x) + q8[2] * bflo(kv.y) + q8[3] * bfhi(kv.y) + q8[4] * bflo(kv.z) + q8[5] * bfhi(kv.z) + q8[6] * bflo(kv.w) + q8[7] * bfhi(kv.w); }
                    s += slope2 * (float)(kp - t); wscr[key] = s; mx = fmaxf(mx, s); } }
            mx = wave_max(mx);
            LDS_WAIT(); asm volatile("" ::: "memory");
            float l = exp2f(sink2 - mx), o = 0.f;
            const bf16* vr = VB + (size_t)kp0 * 256 + 64 * hkv + lane;
            for (int key = 0; key < nkeys; ++key) { const float p = exp2f(wscr[key] - mx); l += p; o += p * bf2f(vr[(size_t)key * 256]); }
            OB[(size_t)t * 1024 + 64 * h + lane] = (bf16)f2bf(o / l);
            LDS_WAIT(); asm volatile("" ::: "memory");
        }
    }
}

__device__ __forceinline__ void phase7(Ctx& F) {
    LAS float* gm = (LAS float*)(F.lds + RING_OFF);
    LAS float* gsf = gm + DM;
    LAS float* shf = gsf + DM;
    const float* MOD = (const float*)(F.ws + WS_MOD);
    for (int n = F.tid; n < DM; n += NTHREADS) { gm[n] = MOD[2 * DM + n] * F.in[I_GPOST][n]; gsf[n] = F.in[I_GPREF][n] * (1.0f + MOD[4 * DM + n]); shf[n] = MOD[3 * DM + n]; }
    __syncthreads();
    const int gw = F.vcu * NWAVES + F.wave, NGW = F.G * NWAVES, lane = F.lane;
    const float* Y = (const float*)(F.ws + WS_Y); const float* SSQ = (const float*)(F.ws + WS_SSQ); const float* WRT = (const float*)(F.ws + WS_WRT);
    bf16* XN = (bf16*)(F.ws + WS_XN); float* EW = (float*)(F.ws + WS_EW); int* LIST = (int*)(F.ws + WS_LIST);
    gu32* CNT = (gu32*)(F.ws + WS_CTL) + CW_CNT;
    constexpr int R = 2;
    for (int m0 = gw * R; m0 < S; m0 += NGW * R) {
        f32x4 h[R][8];
#pragma unroll
        for (int r = 0; r < R; ++r) { const int m = m0 + r;
            const float ssq = wave_sum(lane < 32 ? SSQ[(size_t)m * 32 + lane] : 0.f);
            const float rstdy = 1.0f / sqrtf(ssq * (1.0f / DM) + RMS_EPS);
            const GAS f32x4* yr = (const GAS f32x4*)(Y + (size_t)m * DM) + lane; const GAS f32x4* xr = (const GAS f32x4*)(F.in[I_X] + (size_t)m * DM) + lane;
            GAS f32x4* xo = (GAS f32x4*)(F.out + (size_t)m * DM) + lane; float s2 = 0.f;
#pragma unroll
            for (int j = 0; j < 8; ++j) { const int d = 4 * lane + 256 * j; const f32x4 g4 = *(const LAS f32x4*)(gm + d);
                const f32x4 xm = xr[64 * j] + g4 * (yr[64 * j] * rstdy); xo[64 * j] = xm; h[r][j] = xm;
                s2 += (xm.x * xm.x + xm.y * xm.y) + (xm.z * xm.z + xm.w * xm.w); }
            const float rstd2 = 1.0f / sqrtf(wave_sum(s2) * (1.0f / DM) + RMS_EPS);
            GAS unsigned long long* o8 = (GAS unsigned long long*)(XN + (size_t)m * DM) + lane;
#pragma unroll
            for (int j = 0; j < 8; ++j) { const int d = 4 * lane + 256 * j; const f32x4 g4 = *(const LAS f32x4*)(gsf + d), s4 = *(const LAS f32x4*)(shf + d);
                const f32x4 hv = h[r][j] * rstd2 * g4 + s4; h[r][j] = hv;
                o8[64 * j] = (unsigned long long)pk2(hv.x, hv.y) | ((unsigned long long)pk2(hv.z, hv.w) << 32); }
            asm volatile("" ::: "memory");
        }
        float lg[R];
#pragma unroll
        for (int r = 0; r < R; ++r) lg[r] = 0.f;
#pragma unroll 1
        for (int o = 0; o < 36; ++o) {
            const GAS f32x4* wr_ = (const GAS f32x4*)(WRT + (size_t)o * DM) + lane;
            float p[R];
#pragma unroll
            for (int r = 0; r < R; ++r) p[r] = 0.f;
#pragma unroll
            for (int j = 0; j < 8; ++j) { const f32x4 w = wr_[64 * j];
#pragma unroll
                for (int r = 0; r < R; ++r) p[r] += (h[r][j].x * w.x + h[r][j].y * w.y) + (h[r][j].z * w.z + h[r][j].w * w.w); }
            const float bias = (o < 4) ? F.in[I_BRG][o] : F.in[I_BRE][o - 4];
#pragma unroll
            for (int r = 0; r < R; ++r) { const float t = wave_sum(p[r]) + bias; lg[r] = (lane == o) ? t : lg[r]; }
        }
#pragma unroll
        for (int r = 0; r < R; ++r) { const int m = m0 + r;
            const float g0 = __shfl(lg[r], 0), g1 = __shfl(lg[r], 1), g2 = __shfl(lg[r], 2), g3 = __shfl(lg[r], 3);
            int gsel = 0; float gmax = g0;
            if (g1 > gmax) { gmax = g1; gsel = 1; } if (g2 > gmax) { gmax = g2; gsel = 2; } if (g3 > gmax) { gmax = g3; gsel = 3; }
            const float gw_ = 1.0f / (expf(g0 - gmax) + expf(g1 - gmax) + expf(g2 - gmax) + expf(g3 - gmax));
            float t0 = -INFINITY, t1 = -INFINITY; int j0 = 0, j1 = 0;
#pragma unroll
            for (int i = 0; i < 8; ++i) { const float v = __shfl(lg[r], 4 + 8 * gsel + i);
                if (v > t0) { t1 = t0; j1 = j0; t0 = v; j0 = i; } else if (v > t1) { t1 = v; j1 = i; } }
            const float e1 = expf(t1 - t0), w0 = gw_ / (1.0f + e1), w1 = gw_ * e1 / (1.0f + e1);
            if (lane == 0) {
                const int ea = gsel * 8 + j0, eb = gsel * 8 + j1;
                const int pa = (int)__hip_atomic_fetch_add(CNT + ea, 1u, RLX_AGENT), pb = (int)__hip_atomic_fetch_add(CNT + eb, 1u, RLX_AGENT);
                LIST[ea * S + pa] = 2 * m; LIST[eb * S + pb] = 2 * m + 1; EW[2 * m] = w0; EW[2 * m + 1] = w1; }
        }
    }
    __syncthreads();
}

__device__ __forceinline__ void phase8(Ctx& F) {
    build_mts(F);
    volatile LAS int* mts = (volatile LAS int*)(F.lds + LDSCTL_OFF) + 64;
    const int gw = F.vcu * NWAVES + F.wave, NGW = F.G * NWAVES, lane = F.lane;
    const int total = mts[32] * 256;
    const bf16* XN = (const bf16*)(F.ws + WS_XN); bf16* XG = (bf16*)(F.ws + WS_XG); const float* EW = (const float*)(F.ws + WS_EW); const int* LIST = (const int*)(F.ws + WS_LIST);
    int2* DESC = (int2*)(F.ws + WS_DESC); const gu32* CNT = (const gu32*)(F.ws + WS_CTL) + CW_CNT;
    for (int row = gw; row < total; row += NGW) {
        const int mt = row >> 8; int e = 0;
        for (int j = 1; j < 32; ++j) e += (mts[j] <= mt) ? 1 : 0;
        const int pos = row - 256 * mts[e]; const int cnt = (int)__hip_atomic_load(CNT + e, RLX_AGENT);
        GAS v4u* dst = (GAS v4u*)(XG + (size_t)row * DM) + lane;
        if (pos < cnt) { const int ent = LIST[e * S + pos]; const GAS v4u* src = (const GAS v4u*)(XN + (size_t)(ent >> 1) * DM) + lane;
#pragma unroll
            for (int i = 0; i < 4; ++i) dst[64 * i] = src[64 * i];
            if (lane == 0) DESC[row] = make_int2(ent, __float_as_int(EW[ent])); }
        else {
#pragma unroll
            for (int i = 0; i < 4; ++i) dst[64 * i] = (v4u){0u, 0u, 0u, 0u};
            if (lane == 0) DESC[row] = make_int2(-1, 0); }
    }
}

__device__ __forceinline__ void phase11(Ctx& F) {
    LAS float* gf = (LAS float*)(F.lds + RING_OFF);
    const float* MOD = (const float*)(F.ws + WS_MOD);
    for (int n = F.tid; n < DM; n += NTHREADS) gf[n] = MOD[5 * DM + n] * F.in[I_GPOSTF][n];
    __syncthreads();
    const int gw = F.vcu * NWAVES + F.wave, NGW = F.G * NWAVES, lane = F.lane;
    const float* YE = (const float*)(F.ws + WS_YE);
    for (int m = gw; m < S; m += NGW) {
        const GAS f32x4* a = (const GAS f32x4*)(YE + (size_t)(2 * m) * DM) + lane; const GAS f32x4* b = (const GAS f32x4*)(YE + (size_t)(2 * m + 1) * DM) + lane;
        GAS f32x4* xo = (GAS f32x4*)(F.out + (size_t)m * DM) + lane;
        f32x4 v[8]; float s2 = 0.f;
#pragma unroll
        for (int j = 0; j < 8; ++j) { v[j] = a[64 * j] + b[64 * j]; s2 += (v[j].x * v[j].x + v[j].y * v[j].y) + (v[j].z * v[j].z + v[j].w * v[j].w); }
        const float rstd = 1.0f / sqrtf(wave_sum(s2) * (1.0f / DM) + RMS_EPS);
#pragma unroll
        for (int j = 0; j < 8; ++j) { const int d = 4 * lane + 256 * j; const f32x4 g4 = *(const LAS f32x4*)(gf + d); xo[64 * j] = xo[64 * j] + g4 * (v[j] * rstd); }
    }
    __syncthreads();
}

struct Args { const float* in[20]; float* out; unsigned char* ws; int ph_lo, ph_hi, li, pad; };
__global__ void __launch_bounds__(NTHREADS, 2) mega_fwd(Args args) {
    extern __shared__ __attribute__((aligned(16))) unsigned char lds[];
    Ctx F;
#pragma unroll
    for (int i = 0; i < 20; ++i) F.in[i] = args.in[i];
    F.out = args.out; F.ws = args.ws;
    F.lds = (LAS unsigned char*)lds;
    F.tid = threadIdx.x; F.lane = F.tid & 63; F.wave = __builtin_amdgcn_readfirstlane(F.tid >> 6);
    F.G = gridDim.x; { const int bx = blockIdx.x; F.vcu = (F.G % 8 == 0) ? (bx % 8) * (F.G / 8) + bx / 8 : bx; }
    volatile LAS unsigned* MISC = (volatile LAS unsigned*)(F.lds + LDSCTL_OFF);
    for (int u = F.tid; u < 256; u += NTHREADS) MISC[u] = 0u;
    __syncthreads();
    gu32* ctl = (gu32*)(F.ws + WS_CTL);
    XcdBarrier bar; bar.bar = (unsigned*)(ctl + CW_BAR); bar.x = 0; bar.st = nullptr;
    if (N_LAUNCHES != PER_PHASE) bar = xcd_barrier_post((unsigned*)(ctl + CW_BAR), MISC + 8);
    const int lo = args.ph_lo, hi = args.ph_hi;
#ifndef PH_MASK
#define PH_MASK 0xfff
#endif
#define IN(k) (((PH_MASK >> (k)) & 1) && lo <= (k) && (k) < hi)
#define SEAM(k) do { if (IN(k) && IN((k) + 1)) xcd_barrier(bar); } while (0)
    unsigned char* ws = F.ws;
    if (IN(0)) { phase0(F); SEAM(0); }
    if (IN(1)) { phase1(F); SEAM(1); }
    if (IN(2)) { pg8::Gemm g{(const pg8::bf16_t*)(ws + WS_XN), (const pg8::bf16_t*)(ws + WS_WT_IN), S, NIN, DM}; pg8::StaticOrder so; so.init(S, NIN, F.G, (int)blockIdx.x);
        EpiQKVG E{ws}; run_gemm(F, g, so, E); SEAM(2); }
    if (IN(3)) { phase3(F); SEAM(3); }
    if (IN(4)) { attn_naive(F); SEAM(4); }
    if (IN(5)) { pg8::Gemm g{(const pg8::bf16_t*)(ws + WS_OAB), (const pg8::bf16_t*)(ws + WS_WT_OAB), 2 * S, 2 * DM, 1024}; GateOrder go; go.init(F.G, (int)blockIdx.x);
        EpiGate E{ws}; run_gemm(F, g, go, E); SEAM(5); }
    if (IN(6)) { pg8::Gemm g{(const pg8::bf16_t*)(ws + WS_Y1), (const pg8::bf16_t*)(ws + WS_WT_OUT), S, DM, DM}; pg8::StaticOrder so; so.init(S, DM, F.G, (int)blockIdx.x);
        EpiY E{ws}; run_gemm(F, g, so, E); SEAM(6); }
    if (IN(7)) { phase7(F); SEAM(7); }
    if (IN(8)) { phase8(F); SEAM(8); }
    if (IN(9)) { build_mts(F); pg8::Gemm g{(const pg8::bf16_t*)(ws + WS_XG), (const pg8::bf16_t*)(ws + WS_WT_GU), MAXROWS, NEXP * 1024, DM};
        MoeOrder mo{(const volatile LAS int*)(F.lds + LDSCTL_OFF) + 64, 2, F.G, F.vcu}; EpiGU E{ws}; run_gemm(F, g, mo, E); SEAM(9); }
    if (IN(10)) { build_mts(F); pg8::Gemm g{(const pg8::bf16_t*)(ws + WS_ACT), (const pg8::bf16_t*)(ws + WS_WT_D), MAXROWS, NEXP * DM, DEXP};
        MoeOrder mo{(const volatile LAS int*)(F.lds + LDSCTL_OFF) + 64, 3, F.G, F.vcu}; EpiDown E{ws}; run_gemm(F, g, mo, E); SEAM(10); }
    if (IN(11)) { phase11(F); }
#undef IN
#undef SEAM
}

extern "C" void kernel_launch(void* const* d_in, const int* in_sizes, int n_in, void* d_out, int out_size, void* d_ws, size_t ws_size, hipStream_t stream) {
    static int grid = 0;
    if (grid == 0) {
        if (n_in != 20 || out_size != S * DM || ws_size < WS_END) { fprintf(stderr, "kernel_launch: unexpected shapes: n_in %d out %d ws %zu (need %zu)\n", n_in, out_size, ws_size, (size_t)WS_END); grid = -1; return; }
        int dev = 0, cus = 0, per_cu = 0;
        if (hipGetDevice(&dev) != hipSuccess || hipDeviceGetAttribute(&cus, hipDeviceAttributeMultiprocessorCount, dev) != hipSuccess) { fprintf(stderr, "kernel_launch: device query failed\n"); grid = -1; return; }
        if (hipFuncSetAttribute((const void*)mega_fwd, hipFuncAttributeMaxDynamicSharedMemorySize, LDS_BYTES) != hipSuccess) { fprintf(stderr, "kernel_launch: hipFuncSetAttribute failed\n"); grid = -1; return; }
        if (hipOccupancyMaxActiveBlocksPerMultiprocessor(&per_cu, (const void*)mega_fwd, NTHREADS, LDS_BYTES) != hipSuccess || per_cu < 1) { fprintf(stderr, "kernel_launch: occupancy query says %d blocks per CU\n", per_cu); grid = -1; (void)hipGetLastError(); return; }
        grid = cus;
        fprintf(stderr, "kernel_launch: grid %d (occupancy query: %d per CU)\n", grid, per_cu);
    }
    if (grid < 0) return;
    if (hipMemsetAsync((char*)d_ws + WS_CTL, 0, CTL_ZERO_BYTES, stream) != hipSuccess) { fprintf(stderr, "kernel_launch: memset failed\n"); return; }
    Args a{};
    for (int i = 0; i < 20; ++i) a.in[i] = (const float*)d_in[i];
    a.out = (float*)d_out; a.ws = (unsigned char*)d_ws;
    if (N_LAUNCHES == 1) {
        a.ph_lo = 0; a.ph_hi = PER_PHASE; a.li = 0;
        void* kargs[] = {&a};
        hipError_t e = hipLaunchCooperativeKernel((const void*)mega_fwd, dim3(grid), dim3(NTHREADS), kargs, LDS_BYTES, stream);
        if (e != hipSuccess) fprintf(stderr, "kernel_launch: cooperative launch failed: %s (grid %d)\n", hipGetErrorString(e), grid);
    } else {
        for (int li = 0; li < PER_PHASE; ++li) { a.ph_lo = li; a.ph_hi = li + 1; a.li = li;
            hipLaunchKernelGGL(mega_fwd, dim3(grid), dim3(NTHREADS), LDS_BYTES, stream, a);
            const hipError_t le = hipPeekAtLastError(); if (le != hipSuccess) { fprintf(stderr, "kernel_launch: launch %d failed: %s\n", li, hipGetErrorName(le)); break; } }
    }
}
```

```cpp
#include <hip/hip_runtime.h>
#include <cstdio>
#include <cstdint>
#include <cmath>

#ifndef MK_N_LAUNCHES
#define MK_N_LAUNCHES 1
#endif
#ifndef FAST_GEMM
#define FAST_GEMM 1
#endif
#ifndef FAST_ATTN
#define FAST_ATTN 0
#endif
namespace pg8 {
#define PG8_LAS __attribute__((address_space(3)))
typedef unsigned short bf16_t;
typedef short bf16x8 __attribute__((ext_vector_type(8)));
typedef float f32x4 __attribute__((ext_vector_type(4)));
typedef unsigned u32x4 __attribute__((ext_vector_type(4)));
constexpr int BM = 256, BK = 64, HALF = 128, HTB = HALF * BK * 2  , STAGE_BYTES = 8 * HTB, NXCD = 8, WGM = 8;

__host__ __device__ __forceinline__ int lds_byte(int r, int c) { const int st = (r >> 4) * 2 + (c >> 5), rr = r & 15, cc = c & 31, ob = rr * 64 + cc * 2; return st * 1024 + (ob ^ (((ob >> 9) & 1) << 5)); }
__host__ __device__ __forceinline__ void stage_rc(int b, int& R, int& C) { const int st = b / 1024, sb = b % 1024, swz = sb ^ (((sb >> 9) & 1) << 5); R = (st >> 1) * 16 + swz / 64; C = (st & 1) * 32 + (swz % 64) / 2; }
__host__ __device__ __forceinline__ int perm32(int rho) { const int n = rho >> 4, i = rho & 15; return 8 * (i >> 2) + 4 * n + (i & 3); }

struct Unit { int pm, pn; };
struct Gemm { const bf16_t* A; const bf16_t* Bt; int M, N, K; };

struct StaticOrder {
    int nM, nN, nwg, G, c;
    __host__ __device__ void init(int M, int N, int G_, int c_) { nM = M / BM; nN = N / BM; nwg = nM * nN; G = G_; c = c_; }
    __host__ __device__ bool next(int i, Unit& u) const {
        const long L = (long)i * G + c; if (L >= nwg) return false;
        int wgid = (int)L; { const int q = nwg / NXCD, r = nwg % NXCD, xcd = wgid % NXCD, off = wgid / NXCD; wgid = (xcd < r ? xcd * (q + 1) : r * (q + 1) + (xcd - r) * q) + off; }
        const int nig = WGM * nN, gid = wgid / nig, fm = gid * WGM, gsz = (nM - fm) < WGM ? (nM - fm) : WGM;
        u.pm = fm + ((wgid % nig) % gsz); u.pn = (wgid % nig) / gsz; return true;
    }
    __device__ __forceinline__ void a_ready(const Unit&) const {}
    __device__ __forceinline__ void done(const Unit&) const {}
};

__device__ __forceinline__ unsigned cvt_pk_bf16(float lo, float hi) { unsigned r; asm volatile("v_cvt_pk_bf16_f32 %0, %1, %2" : "=v"(r) : "v"(lo), "v"(hi)); return r; }
template <class Epi, class Sched, bool ALIGN_EPI = false, bool SP2 = false>
__device__ __forceinline__ void gemm_phase(PG8_LAS unsigned char* lds, const Gemm g, const Sched& S, const Epi& E) {
    const int tid = threadIdx.x, wid = __builtin_amdgcn_readfirstlane(tid >> 6), lane = tid & 63, wr = wid >> 2, wc = wid & 3, fr = lane & 15, fq = lane >> 4;
    const int K = g.K, nt = K / BK;
    unsigned voffA[2], voffB[2];
#pragma unroll
    for (int i = 0; i < 2; ++i) { int R, C; stage_rc(tid * 16 + i * 8192, R, C); const int Rb = Epi::PERM ? ((R & ~31) + perm32(R & 31)) : R;
        voffA[i] = (unsigned)(R * K + C) * 2u; voffB[i] = (unsigned)(Rb * K + C) * 2u; }
    const size_t kstep = (size_t)(BK * 2);
    const size_t hstep = (size_t)HALF * K * 2;
    const size_t tstep = 2 * hstep;
    const unsigned ldsw = (unsigned)wid * 1024u;
    const int aoff = lds_byte(wr * 64 + fr, fq * 8), boff = lds_byte(wc * 32 + fr, fq * 8);
#define PG8_SA(b, h) (((b) * 2 + (h)) * HTB)
#define PG8_SB(b, h) ((4 + (b) * 2 + (h)) * HTB)
#define PG8_STAGE(bufoff, gbase, voff) do { _Pragma("unroll") for (int _i = 0; _i < 2; ++_i) \
        __builtin_amdgcn_global_load_lds((const unsigned*)((const char*)(gbase) + (voff)[_i]), (PG8_LAS unsigned*)(lds + (bufoff) + ldsw + _i * 8192), 16, 0, 0); } while (0)
#define PG8_LDA(dst, b, h) do { _Pragma("unroll") for (int m = 0; m < 4; ++m) _Pragma("unroll") for (int k = 0; k < 2; ++k) dst[m][k] = *(const PG8_LAS bf16x8*)(lds + PG8_SA(b, h) + aoff + m * 2048 + k * 1024); } while (0)
#define PG8_LDB(dst, b, h) do { _Pragma("unroll") for (int n = 0; n < 2; ++n) _Pragma("unroll") for (int k = 0; k < 2; ++k) dst[n][k] = *(const PG8_LAS bf16x8*)(lds + PG8_SB(b, h) + boff + n * 2048 + k * 1024); } while (0)
#define PG8_MMA(ai, bj, At, Bt) do { __builtin_amdgcn_s_setprio(1); _Pragma("unroll") for (int m = 0; m < 4; ++m) _Pragma("unroll") for (int n = 0; n < 2; ++n) _Pragma("unroll") for (int k = 0; k < 2; ++k) \
        acc[ai][bj][m][n] = __builtin_amdgcn_mfma_f32_16x16x32_bf16(Bt[n][k], At[m][k], acc[ai][bj][m][n], 0, 0, 0); __builtin_amdgcn_s_setprio(0); } while (0)
#define PG8_WAIT_V(n) asm volatile("s_waitcnt vmcnt(" #n ")" ::: "memory")
#define PG8_WAIT_L(n) asm volatile("s_waitcnt lgkmcnt(" #n ")" ::: "memory")
#define PG8_BAR __builtin_amdgcn_s_barrier()
#define PG8_SCHED __builtin_amdgcn_sched_barrier(0)
    Unit cur, nxt; int ui = 0;
    if (!S.next(0, cur)) return;
    f32x4 acc[2][2][4][2];
#pragma unroll
    for (int a = 0; a < 2; ++a)
#pragma unroll
        for (int b = 0; b < 2; ++b)
#pragma unroll
            for (int m = 0; m < 4; ++m)
#pragma unroll
                for (int n = 0; n < 2; ++n) acc[a][b][m][n] = (f32x4){0.f, 0.f, 0.f, 0.f};
    bf16x8 At[4][2], B0[2][2], B1[2][2];
    const char* cA = (const char*)g.A + (size_t)cur.pm * tstep; const char* cB = (const char*)g.Bt + (size_t)cur.pn * tstep;
    S.a_ready(cur);
    if constexpr (SP2) {
        PG8_STAGE(PG8_SB(0, 0), cB, voffB); PG8_STAGE(PG8_SB(0, 1), cB + hstep, voffB); PG8_STAGE(PG8_SA(0, 0), cA, voffA); PG8_STAGE(PG8_SA(0, 1), cA + hstep, voffA);
        if (wr == 1) PG8_BAR;
        PG8_WAIT_V(2); PG8_BAR;
        PG8_STAGE(PG8_SB(1, 0), cB + kstep, voffB); PG8_STAGE(PG8_SA(1, 0), cA + kstep, voffA); PG8_STAGE(PG8_SB(1, 1), cB + hstep + kstep, voffB);
        PG8_WAIT_V(6); PG8_BAR;
    } else {
        PG8_STAGE(PG8_SB(0, 0), cB, voffB); PG8_STAGE(PG8_SA(0, 0), cA, voffA); PG8_STAGE(PG8_SB(0, 1), cB + hstep, voffB); PG8_STAGE(PG8_SA(0, 1), cA + hstep, voffA);
        if (wr == 1) PG8_BAR;
        PG8_WAIT_V(4); PG8_BAR;
        PG8_STAGE(PG8_SB(1, 0), cB + kstep, voffB); PG8_STAGE(PG8_SA(1, 0), cA + kstep, voffA); PG8_STAGE(PG8_SB(1, 1), cB + hstep + kstep, voffB);
        PG8_WAIT_V(6); PG8_BAR;
    }
    for (;;) {
        const bool has_next = S.next(ui + 1, nxt);
        const char* nA = has_next ? (const char*)g.A + (size_t)nxt.pm * tstep : cA; const char* nB = has_next ? (const char*)g.Bt + (size_t)nxt.pn * tstep : cB;
        for (int t = 0; t < nt; t += 2) {
            const bool last = (t == nt - 2);
            const char* a1 = cA + (size_t)(t + 1) * kstep;
            const char* a2 = last ? nA : cA + (size_t)(t + 2) * kstep; const char* b2 = last ? nB : cB + (size_t)(t + 2) * kstep;
            const char* a3 = a2 + kstep; const char* b3 = b2 + kstep;
            if (last && has_next) S.a_ready(nxt);
            if constexpr (SP2) {
            PG8_LDB(B0, 0, 0); PG8_LDB(B1, 0, 1); PG8_SCHED; PG8_LDA(At, 0, 0); PG8_STAGE(PG8_SA(1, 1), a1 + hstep, voffA);
            PG8_WAIT_V(8); PG8_WAIT_L(0); PG8_BAR; PG8_MMA(0, 0, At, B0); PG8_MMA(0, 1, At, B1); PG8_BAR; PG8_SCHED;
            PG8_LDA(At, 0, 1); PG8_STAGE(PG8_SB(0, 0), b2, voffB); PG8_STAGE(PG8_SB(0, 1), b2 + hstep, voffB); PG8_STAGE(PG8_SA(0, 0), a2, voffA);
            PG8_WAIT_V(8); PG8_WAIT_L(0); PG8_BAR; PG8_MMA(1, 0, At, B0); PG8_MMA(1, 1, At, B1); PG8_BAR; PG8_SCHED;
            PG8_LDB(B0, 1, 0); PG8_LDB(B1, 1, 1); PG8_SCHED; PG8_LDA(At, 1, 0); PG8_STAGE(PG8_SA(0, 1), a2 + hstep, voffA);
            PG8_WAIT_V(8); PG8_WAIT_L(0); PG8_BAR; PG8_MMA(0, 0, At, B0); PG8_MMA(0, 1, At, B1); PG8_BAR; PG8_SCHED;
            PG8_LDA(At, 1, 1); PG8_STAGE(PG8_SB(1, 0), b3, voffB); PG8_STAGE(PG8_SB(1, 1), b3 + hstep, voffB); PG8_STAGE(PG8_SA(1, 0), a3, voffA);
            PG8_WAIT_V(8); PG8_WAIT_L(0); PG8_BAR; PG8_MMA(1, 0, At, B0); PG8_MMA(1, 1, At, B1); PG8_BAR; PG8_SCHED;
            } else {
            PG8_LDB(B0, 0, 0); PG8_SCHED; PG8_LDA(At, 0, 0); PG8_STAGE(PG8_SA(1, 1), a1 + hstep, voffA);
            PG8_WAIT_L(8); PG8_BAR; PG8_WAIT_L(0); PG8_MMA(0, 0, At, B0); PG8_BAR; PG8_SCHED;
            PG8_LDB(B1, 0, 1); PG8_STAGE(PG8_SB(0, 0), b2, voffB);
            PG8_BAR; PG8_WAIT_L(0); PG8_MMA(0, 1, At, B1); PG8_BAR;
            PG8_LDA(At, 0, 1); PG8_STAGE(PG8_SA(0, 0), a2, voffA);
            PG8_BAR; PG8_WAIT_L(0); PG8_MMA(1, 0, At, B0); PG8_BAR; PG8_SCHED;
            PG8_STAGE(PG8_SB(0, 1), b2 + hstep, voffB);
            PG8_WAIT_V(6); PG8_BAR; PG8_MMA(1, 1, At, B1); PG8_BAR;
            PG8_LDB(B0, 1, 0); PG8_SCHED; PG8_LDA(At, 1, 0); PG8_STAGE(PG8_SA(0, 1), a2 + hstep, voffA);
            PG8_WAIT_L(8); PG8_BAR; PG8_WAIT_L(0); PG8_MMA(0, 0, At, B0); PG8_BAR; PG8_SCHED;
            PG8_LDB(B1, 1, 1); PG8_STAGE(PG8_SB(1, 0), b3, voffB);
            PG8_BAR; PG8_WAIT_L(0); PG8_MMA(0, 1, At, B1); PG8_BAR;
            PG8_LDA(At, 1, 1); PG8_STAGE(PG8_SA(1, 0), a3, voffA);
            PG8_BAR; PG8_WAIT_L(0); PG8_MMA(1, 0, At, B0); PG8_BAR; PG8_SCHED;
            PG8_STAGE(PG8_SB(1, 1), b3 + hstep, voffB);
            PG8_WAIT_V(6); PG8_BAR; PG8_MMA(1, 1, At, B1); PG8_BAR;
            }
        }
        if constexpr (ALIGN_EPI) { if (wr == 0) PG8_BAR; }
        if constexpr (!Epi::AFTER_DRAIN) { E(acc, cur, wr, wc, fr, fq); S.done(cur); }
        if (!has_next) break;
#pragma unroll
        for (int a = 0; a < 2; ++a)
#pragma unroll
            for (int b = 0; b < 2; ++b)
#pragma unroll
                for (int m = 0; m < 4; ++m)
#pragma unroll
                    for (int n = 0; n < 2; ++n) acc[a][b][m][n] = (f32x4){0.f, 0.f, 0.f, 0.f};
        cur = nxt; cA = nA; cB = nB; ++ui;
        if constexpr (ALIGN_EPI) { if (wr == 1) PG8_BAR; }
    }
    PG8_WAIT_V(0);
    if constexpr (!ALIGN_EPI) { if (wr == 0) PG8_BAR; }
    PG8_BAR;
    if constexpr (Epi::AFTER_DRAIN) { E.fused(acc, cur, wr, wc, fr, fq, lds, wid, lane); S.done(cur); }
#undef PG8_SA
#undef PG8_SB
#undef PG8_STAGE
#undef PG8_LDA
#undef PG8_LDB
#undef PG8_MMA
#undef PG8_WAIT_V
#undef PG8_WAIT_L
#undef PG8_BAR
#undef PG8_SCHED
}
}
#define GAS __attribute__((address_space(1)))
#define LAS __attribute__((address_space(3)))
typedef unsigned short bf16;
typedef unsigned v4u __attribute__((ext_vector_type(4)));
typedef float f32x4 __attribute__((ext_vector_type(4)));
typedef short bf16x8 __attribute__((ext_vector_type(8)));
typedef GAS unsigned gu32;
typedef GAS unsigned long long gu64;
#define RLX_AGENT __ATOMIC_RELAXED, __HIP_MEMORY_SCOPE_AGENT
#define LDS_WAIT() asm volatile("s_waitcnt lgkmcnt(0)" ::: "memory")
#define VM_WAIT() asm volatile("s_waitcnt vmcnt(0)" ::: "memory")
__device__ __forceinline__ unsigned long long rt() { return __builtin_amdgcn_s_memrealtime(); }
__device__ __forceinline__ unsigned f2bf(float f) { unsigned u = __builtin_bit_cast(unsigned, f); return (u + 0x7fffu + ((u >> 16) & 1u)) >> 16; }
__device__ __forceinline__ unsigned pk2(float lo, float hi) { return f2bf(lo) | (f2bf(hi) << 16); }

#define XB_TMO      128
#define XB_XCNT(j)  (256  + 64 * (j))
#define XB_XSUB(j)  (1280 + 64 * (j))
#define XB_XGEN(j)  (2304 + 64 * (j))
#define XB_TOP      3328
#define XB_TOPGEN   3392
#define XCD_BAR_WORDS 3456
#define XB_SPIN_CAP (1u << 18)

__device__ __forceinline__ unsigned xb_ld(unsigned* p)              { return __hip_atomic_load(p, __ATOMIC_RELAXED, __HIP_MEMORY_SCOPE_AGENT); }
__device__ __forceinline__ unsigned xb_add(unsigned* p, unsigned v) { return __hip_atomic_fetch_add(p, v, __ATOMIC_RELAXED, __HIP_MEMORY_SCOPE_AGENT); }
__device__ __forceinline__ unsigned xb_xcc_id() { return (unsigned)__builtin_amdgcn_s_getreg((3 << 11) | 20) & 0xFu; }
#define XB_SPIN(cond, bar) do { unsigned _sp = 0; while (cond) { __builtin_amdgcn_s_sleep(1); \
    if ((++_sp & 255u) == 0u) { if (xb_ld(&(bar)[XB_TMO])) break; if (_sp > XB_SPIN_CAP) { atomicAdd(&(bar)[XB_TMO], 1u); break; } } } } while (0)

struct XcdBarrier {
    unsigned* bar; unsigned x;
    volatile LAS unsigned* st;
};

__device__ __forceinline__ XcdBarrier xcd_barrier_post(unsigned* bar, volatile LAS unsigned* st) {
    XcdBarrier b; b.bar = bar; b.x = xb_xcc_id(); b.st = st;
    if (threadIdx.x == 0) (void)xb_add(&bar[XB_XCNT(b.x)], 1u);
    return b;
}
__device__ __forceinline__ void xcd_barrier_complete(unsigned* bar, unsigned x, unsigned& nloc, unsigned& nx) {
    const unsigned G = gridDim.x * gridDim.y * gridDim.z;
    unsigned sum, cnt, mine, sp = 0u;
    for (;;) {
        sum = 0u; cnt = 0u; mine = 0u;
#pragma unroll
        for (unsigned j = 0; j < 16; ++j) { const unsigned c = xb_ld(&bar[XB_XCNT(j)]); sum += c; cnt += (c > 0u) ? 1u : 0u; mine = (j == x) ? c : mine; }
        if (sum == G) break;
        __builtin_amdgcn_s_sleep(1);
        if ((++sp & 255u) == 0u) { if (xb_ld(&bar[XB_TMO])) break; if (sp > XB_SPIN_CAP) { atomicAdd(&bar[XB_TMO], 1u); break; } }
    }
    nloc = mine > 0u ? mine : 1u; nx = cnt > 0u ? cnt : 1u;
}

__device__ __forceinline__ void xcd_barrier(const XcdBarrier& b) {
    asm volatile("s_waitcnt vmcnt(0)" ::: "memory");
    __syncthreads();
    if (threadIdx.x == 0) {
        unsigned* bar = b.bar;
        __builtin_amdgcn_s_waitcnt(0);
        unsigned nloc = b.st[0], nx = b.st[1];
        if (nloc == 0u) { xcd_barrier_complete(bar, b.x, nloc, nx); b.st[0] = nloc; b.st[1] = nx; }
        const unsigned old = xb_add(&bar[XB_XSUB(b.x)], 1u);
        const unsigned gen = old / nloc;
        if (old + 1u == (gen + 1u) * nloc) {
            __builtin_amdgcn_fence(__ATOMIC_RELEASE, "agent");
            asm volatile("s_waitcnt vmcnt(0)" ::: "memory");
            const unsigned og = xb_add(&bar[XB_TOP], 1u);
            const unsigned tg = og / nx;
            if (og + 1u == (tg + 1u) * nx) xb_add(&bar[XB_TOPGEN], 1u);
            else XB_SPIN(xb_ld(&bar[XB_TOPGEN]) == tg, bar);
            __builtin_amdgcn_fence(__ATOMIC_ACQUIRE, "agent");
            xb_add(&bar[XB_XGEN(b.x)], 1u);
            asm volatile("s_waitcnt vmcnt(0)" ::: "memory");
        } else {
            XB_SPIN(xb_ld(&bar[XB_XGEN(b.x)]) == gen, bar);
            __builtin_amdgcn_fence(__ATOMIC_ACQUIRE, "agent");
            asm volatile("s_waitcnt vmcnt(0)" ::: "memory");
        }
    }
    __syncthreads();
}

constexpr int S = 8192, DM = 2048, HD = 64, NH = 16;
constexpr int NIN = 8704, NEXP = 32, DEXP = 512, NMOD = 12288;
constexpr float RMS_EPS = 1e-6f;
constexpr float LOG2E = 1.4426950408889634f;
constexpr float C2 = 0.125f * LOG2E;
constexpr int NWAVES = 8, NTHREADS = 512;
constexpr int PER_PHASE = 12;
constexpr int N_LAUNCHES = MK_N_LAUNCHES;

constexpr size_t MiB = 1u << 20;
constexpr size_t WS_CTL = 0, CTL_ZERO_BYTES = 1 * MiB;
constexpr size_t WS_MODP = 1 * MiB;
constexpr size_t WS_MOD = WS_MODP + 1536 * 1024;
constexpr size_t WS_KMEAN = WS_MOD + 64 * 1024;
constexpr size_t WS_WRT = WS_KMEAN + 128 * 1024;
constexpr size_t WS_SSQ = WS_WRT + 288 * 1024;
constexpr size_t WS_EW = WS_SSQ + MiB;
constexpr size_t WS_LIST = WS_EW + 64 * 1024;
constexpr size_t WS_DESC = WS_LIST + MiB;
constexpr size_t WS_SMALL_END = WS_DESC + 192 * 1024;
static_assert(WS_SMALL_END <= 6 * MiB, "small region");
constexpr size_t WS_WT_OAB = 6 * MiB;
constexpr size_t WS_WT_OUT = 14 * MiB;
constexpr size_t WS_WT_IN = 22 * MiB;
constexpr size_t WS_WT_GU = 56 * MiB;
constexpr size_t WS_WT_D = 184 * MiB;
constexpr size_t WS_XN = 248 * MiB;
constexpr size_t WS_QA = 280 * MiB, WS_KA = 296 * MiB, WS_VA = 312 * MiB, WS_QB = 328 * MiB, WS_KB = 344 * MiB, WS_VB = 348 * MiB;
constexpr size_t WS_SGA = 352 * MiB, WS_SGB = 384 * MiB;
constexpr size_t WS_Y1 = 416 * MiB;
constexpr size_t WS_Y = 448 * MiB;
constexpr size_t WS_TMPA = 512 * MiB;
constexpr size_t WS_OAB = 576 * MiB;
constexpr size_t WS_END = 608 * MiB;
constexpr size_t WS_YE = 280 * MiB;
constexpr size_t WS_ACT = 416 * MiB;
constexpr size_t WS_XG = 448 * MiB;
constexpr int MAXROWS = 24576;
static_assert(WS_XG + (size_t)MAXROWS * DM * 2 <= WS_OAB && WS_YE + (size_t)S * 2 * DM * 4 <= WS_Y1, "overlays");
constexpr int CW_TMO = 0, CW_CODE = 1, CW_BAR = 4096, CW_CNT = 8192;

constexpr int RING_OFF = 0, RING_BYTES = 131072;
constexpr int LDSCTL_OFF = RING_BYTES;
constexpr int LDS_BYTES = 147456;

typedef unsigned u32x4_t __attribute__((ext_vector_type(4)));
typedef float f32x2_t __attribute__((ext_vector_type(2)));

__device__ __forceinline__ float bf2f(unsigned short b) { return __uint_as_float(((unsigned)b) << 16); }
__device__ __forceinline__ float bflo(unsigned w) { return __uint_as_float(w << 16); }
__device__ __forceinline__ float bfhi(unsigned w) { return __uint_as_float(w & 0xffff0000u); }
__device__ __forceinline__ float wave_sum(float v) {
#pragma unroll
    for (int o = 1; o < 64; o <<= 1) v += __shfl_xor(v, o);
    return v;
}
__device__ __forceinline__ float wave_max(float v) {
#pragma unroll
    for (int o = 1; o < 64; o <<= 1) v = fmaxf(v, __shfl_xor(v, o));
    return v;
}
__device__ __forceinline__ float sigmoidf_(float v) { return __builtin_amdgcn_rcpf(1.0f + __builtin_amdgcn_exp2f(-v * LOG2E)); }

struct Ctx {
    const float* in[20]; float* out; unsigned char* ws;
    int tid, lane, wave, G, vcu;
    LAS unsigned char* lds;
};
enum { I_X = 0, I_C, I_WADA, I_BADA, I_GPRE, I_GPOST, I_WIN, I_SINKS, I_WOA, I_WOB, I_WOUT, I_GPREF, I_GPOSTF, I_WRG, I_BRG, I_WRE, I_BRE, I_WG, I_WU, I_WD };

__device__ __forceinline__ void tr_item(const float* W, int N, bf16* WT, int ldt, int wt_row0, int k0, int n0, LAS float* scr, int lane) {
#pragma unroll 8
    for (int i = 0; i < 32; ++i) { const int kk = 2 * i + (lane >> 5); scr[kk * 33 + (lane & 31)] = W[(size_t)(k0 + kk) * N + n0 + (lane & 31)]; }
    LDS_WAIT(); asm volatile("" ::: "memory");
    const int c = lane & 7;
#pragma unroll
    for (int j = 0; j < 4; ++j) { const int n = (lane >> 3) + 8 * j; const LAS float* s = scr + (8 * c) * 33 + n;
        v4u o; o.x = pk2(s[0 * 33], s[1 * 33]); o.y = pk2(s[2 * 33], s[3 * 33]); o.z = pk2(s[4 * 33], s[5 * 33]); o.w = pk2(s[6 * 33], s[7 * 33]);
        *(GAS v4u*)(WT + (size_t)(wt_row0 + n) * ldt + k0 + 8 * c) = o; }
    LDS_WAIT(); asm volatile("" ::: "memory");
}
__device__ __forceinline__ void phase0(Ctx& F) {
    LAS float* scr = (LAS float*)(F.lds + RING_OFF + F.wave * 16384);
    const int gw = F.vcu * NWAVES + F.wave, NGW = F.G * NWAVES, lane = F.lane;
    constexpr int I_GEMV = 32 * 48, I_RT = 36;
    constexpr int I_IN = 32 * 272, I_OA = 16 * 64, I_OUT = 32 * 64, I_E = 32 * 512;
    constexpr int NITEMS = I_GEMV + I_RT + I_IN + 2 * I_OA + I_OUT + 3 * I_E;
    bf16* WT_OAB = (bf16*)(F.ws + WS_WT_OAB); bf16* WT_OUT = (bf16*)(F.ws + WS_WT_OUT); bf16* WT_IN = (bf16*)(F.ws + WS_WT_IN);
    bf16* WT_GU = (bf16*)(F.ws + WS_WT_GU); bf16* WT_D = (bf16*)(F.ws + WS_WT_D);
    for (int it = gw; it < NITEMS; it += NGW) {
        int r = it;
        if (r < I_GEMV) {
            const int kc = r / 48, span = r % 48;
            const float cv = F.in[I_C][64 * kc + lane];
            const float sv = cv / (1.0f + expf(-cv));
            f32x4 acc = {0.f, 0.f, 0.f, 0.f};
            const float* wp = F.in[I_WADA] + (size_t)(64 * kc) * NMOD + 256 * span + 4 * lane;
#pragma unroll 8
            for (int rr = 0; rr < 64; ++rr) { const f32x4 w = *(const GAS f32x4*)(wp + (size_t)rr * NMOD); const float s = __shfl(sv, rr); acc += w * s; }
            *(GAS f32x4*)((float*)(F.ws + WS_MODP) + (size_t)kc * NMOD + 256 * span + 4 * lane) = acc;
            continue;
        }
        r -= I_GEMV;
        if (r < I_RT) {
            float* wrt = (float*)(F.ws + WS_WRT) + (size_t)r * DM;
            for (int d = lane; d < DM; d += 64) wrt[d] = (r < 4) ? F.in[I_WRG][d * 4 + r] : F.in[I_WRE][d * 32 + (r - 4)];
            continue;
        }
        r -= I_RT;
        if (r < I_IN) { const int kb = r / 272, nb = r % 272; tr_item(F.in[I_WIN], NIN, WT_IN, DM, 32 * nb, 64 * kb, 32 * nb, scr, lane); continue; }
        r -= I_IN;
        if (r < I_OA) { const int kb = r / 64, nb = r % 64; tr_item(F.in[I_WOA], DM, WT_OAB, 1024, 32 * nb, 64 * kb, 32 * nb, scr, lane); continue; }
        r -= I_OA;
        if (r < I_OA) { const int kb = r / 64, nb = r % 64; tr_item(F.in[I_WOB], DM, WT_OAB + (size_t)DM * 1024, 1024, 32 * nb, 64 * kb, 32 * nb, scr, lane); continue; }
        r -= I_OA;
        if (r < I_OUT) { const int kb = r / 64, nb = r % 64; tr_item(F.in[I_WOUT], DM, WT_OUT, DM, 32 * nb, 64 * kb, 32 * nb, scr, lane); continue; }
        r -= I_OUT;
        if (r < I_E) { const int e = r / 512, rr = r % 512, kb = rr / 16, nb = rr % 16, n0 = 32 * nb;
            tr_item(F.in[I_WG] + (size_t)e * DM * DEXP, DEXP, WT_GU, DM, e * 1024 + 256 * (n0 >> 7) + (n0 & 127), 64 * kb, n0, scr, lane); continue; }
        r -= I_E;
        if (r < I_E) { const int e = r / 512, rr = r % 512, kb = rr / 16, nb = rr % 16, n0 = 32 * nb;
            tr_item(F.in[I_WU] + (size_t)e * DM * DEXP, DEXP, WT_GU, DM, e * 1024 + 256 * (n0 >> 7) + 128 + (n0 & 127), 64 * kb, n0, scr, lane); continue; }
        r -= I_E;
        { const int e = r / 512, rr = r % 512, kb = rr / 64, nb = rr % 64;
            tr_item(F.in[I_WD] + (size_t)e * DEXP * DM, DM, WT_D, DEXP, e * 2048 + 32 * nb, 64 * kb, 32 * nb, scr, lane); }
    }
}

__device__ __forceinline__ float mod_value(const Ctx& F, int n) {
    const float* mp = (const float*)(F.ws + WS_MODP) + n;
    float s = F.in[I_BADA][n];
#pragma unroll 8
    for (int kc = 0; kc < 32; ++kc) s += mp[(size_t)kc * NMOD];
    return s;
}
__device__ __forceinline__ void phase1(Ctx& F) {
    LAS float* gs = (LAS float*)(F.lds + RING_OFF);
    LAS float* sh = gs + DM;
    for (int n = F.tid; n < DM; n += NTHREADS) { const float shv = mod_value(F, n), scv = mod_value(F, DM + n); gs[n] = F.in[I_GPRE][n] * (1.0f + scv); sh[n] = shv; }
    { const int per = NMOD / F.G + 1; const int n = blockIdx.x * per + F.tid; if (F.tid < per && n < NMOD) ((float*)(F.ws + WS_MOD))[n] = mod_value(F, n); }
    __syncthreads();
    const int gw = F.vcu * NWAVES + F.wave, NGW = F.G * NWAVES, lane = F.lane;
    bf16* XN = (bf16*)(F.ws + WS_XN);
    for (int m = gw; m < S; m += NGW) {
        const GAS f32x4* xr = (const GAS f32x4*)(F.in[I_X] + (size_t)m * DM) + lane;
        f32x4 v[8]; float s2 = 0.f;
#pragma unroll
        for (int j = 0; j < 8; ++j) { v[j] = xr[64 * j]; s2 += (v[j].x * v[j].x + v[j].y * v[j].y) + (v[j].z * v[j].z + v[j].w * v[j].w); }
        const float rstd = 1.0f / sqrtf(wave_sum(s2) * (1.0f / DM) + RMS_EPS);
        GAS unsigned long long* o8 = (GAS unsigned long long*)(XN + (size_t)m * DM) + lane;
#pragma unroll
        for (int j = 0; j < 8; ++j) { const int d = 4 * lane + 256 * j; const f32x4 g4 = *(const LAS f32x4*)(gs + d), s4 = *(const LAS f32x4*)(sh + d);
            const f32x4 h = v[j] * rstd * g4 + s4;
            o8[64 * j] = (unsigned long long)pk2(h.x, h.y) | ((unsigned long long)pk2(h.z, h.w) << 32); }
    }
    __syncthreads();
}

template <class Epi, class Sched>
__device__ __forceinline__ void gemm_naive(const pg8::Gemm g, const Sched& Sc, const Epi& E) {
    using namespace pg8;
    const int tid = threadIdx.x, wid = __builtin_amdgcn_readfirstlane(tid >> 6), lane = tid & 63, wr = wid >> 2, wc = wid & 3, fr = lane & 15, fq = lane >> 4;
    const int K = g.K;
    Unit u;
    for (int i = 0; Sc.next(i, u); ++i) {
        pg8::f32x4 acc[2][2][4][2];
#pragma unroll
        for (int a = 0; a < 2; ++a)
#pragma unroll
            for (int b = 0; b < 2; ++b)
#pragma unroll
                for (int m = 0; m < 4; ++m)
#pragma unroll
                    for (int n = 0; n < 2; ++n) acc[a][b][m][n] = (pg8::f32x4){0.f, 0.f, 0.f, 0.f};
        const bf16_t* Ab = g.A + (size_t)u.pm * 256 * K; const bf16_t* Bb = g.Bt + (size_t)u.pn * 256 * K;
        const bf16_t* Ap = Ab + (size_t)(64 * wr + fr) * K + 8 * fq;
        const bf16_t* Bp = Bb + (size_t)(32 * wc) * K + 8 * fq;
        const int c0 = Epi::PERM ? perm32(fr) : fr, c1 = Epi::PERM ? perm32(16 + fr) : 16 + fr;
#pragma unroll 1
        for (int k0 = 0; k0 < K; k0 += 32) {
            pg8::bf16x8 b[2][2];
#pragma unroll
            for (int bj = 0; bj < 2; ++bj) { b[bj][0] = *(const pg8::bf16x8*)(Bp + (size_t)(128 * bj + c0) * K + k0); b[bj][1] = *(const pg8::bf16x8*)(Bp + (size_t)(128 * bj + c1) * K + k0); }
#pragma unroll
            for (int ai = 0; ai < 2; ++ai) {
                pg8::bf16x8 a[4];
#pragma unroll
                for (int m = 0; m < 4; ++m) a[m] = *(const pg8::bf16x8*)(Ap + (size_t)(128 * ai + 16 * m) * K + k0);
#pragma unroll
                for (int bj = 0; bj < 2; ++bj)
#pragma unroll
                    for (int m = 0; m < 4; ++m)
#pragma unroll
                        for (int n = 0; n < 2; ++n) acc[ai][bj][m][n] = __builtin_amdgcn_mfma_f32_16x16x32_bf16(b[bj][n], a[m], acc[ai][bj][m][n], 0, 0, 0);
                asm volatile("" ::: "memory");
            }
        }
        E(acc, u, wr, wc, fr, fq);
    }
}
template <class Epi, class Sched>
__device__ __forceinline__ void run_gemm(Ctx& F, const pg8::Gemm g, const Sched& Sc, const Epi& E) {
#if FAST_GEMM
    pg8::gemm_phase<Epi, Sched, true, true>((PG8_LAS unsigned char*)(F.lds + RING_OFF), g, Sc, E);
#else
    gemm_naive<Epi, Sched>(g, Sc, E);
#endif
}

typedef pg8::f32x4 acc_t[2][2][4][2];
struct EpiQKVG {
    static constexpr bool PERM = true, AFTER_DRAIN = false;
    unsigned char* ws;
    __device__ __forceinline__ void operator()(const acc_t& acc, const pg8::Unit& u, int wr, int wc, int fr, int fq) const {
        const int pn = u.pn; bf16* base; int ldc, colt; float sc = 1.0f; bool sig = false;
        if (pn < 4) { base = (bf16*)(ws + WS_QA); ldc = 1024; colt = 256 * pn; sc = C2; }
        else if (pn < 8) { base = (bf16*)(ws + WS_KA); ldc = 1024; colt = 256 * (pn - 4); }
        else if (pn < 12) { base = (bf16*)(ws + WS_VA); ldc = 1024; colt = 256 * (pn - 8); }
        else if (pn < 16) { base = (bf16*)(ws + WS_QB); ldc = 1024; colt = 256 * (pn - 12); sc = C2; }
        else if (pn == 16) { base = (bf16*)(ws + WS_KB); ldc = 256; colt = 0; }
        else if (pn == 17) { base = (bf16*)(ws + WS_VB); ldc = 256; colt = 0; }
        else if (pn < 26) { base = (bf16*)(ws + WS_SGA); ldc = 2048; colt = 256 * (pn - 18); sig = true; }
        else { base = (bf16*)(ws + WS_SGB); ldc = 2048; colt = 256 * (pn - 26); sig = true; }
        const int row0 = u.pm * 256 + wr * 64 + fr, col0 = colt + wc * 32 + 8 * fq;
#pragma unroll
        for (int ai = 0; ai < 2; ++ai)
#pragma unroll
            for (int m = 0; m < 4; ++m) { bf16* rowp = base + (size_t)(row0 + ai * 128 + m * 16) * ldc + col0;
#pragma unroll
                for (int bj = 0; bj < 2; ++bj) { pg8::f32x4 v0 = acc[ai][bj][m][0], v1 = acc[ai][bj][m][1];
                    if (sig) { v0 = (pg8::f32x4){sigmoidf_(v0[0]), sigmoidf_(v0[1]), sigmoidf_(v0[2]), sigmoidf_(v0[3])}; v1 = (pg8::f32x4){sigmoidf_(v1[0]), sigmoidf_(v1[1]), sigmoidf_(v1[2]), sigmoidf_(v1[3])}; }
                    else { v0 = v0 * sc; v1 = v1 * sc; }
                    pg8::u32x4 w; w.x = pg8::cvt_pk_bf16(v0[0], v0[1]); w.y = pg8::cvt_pk_bf16(v0[2], v0[3]); w.z = pg8::cvt_pk_bf16(v1[0], v1[1]); w.w = pg8::cvt_pk_bf16(v1[2], v1[3]);
                    *(pg8::u32x4*)(rowp + bj * 128) = w; } }
    }
};
struct EpiGate {
    static constexpr bool PERM = true, AFTER_DRAIN = false;
    unsigned char* ws;
    __device__ __forceinline__ void operator()(const acc_t& acc, const pg8::Unit& u, int wr, int wc, int fr, int fq) const {
        const int which = u.pm >> 5, pm = u.pm & 31, pn = u.pn & 7;
        const bf16* SG = (const bf16*)(ws + (which ? WS_SGB : WS_SGA)); float* T = (float*)(ws + WS_TMPA); bf16* Y1 = (bf16*)(ws + WS_Y1);
        const int row0 = pm * 256 + wr * 64 + fr, col0 = pn * 256 + wc * 32 + 8 * fq;
#pragma unroll
        for (int ai = 0; ai < 2; ++ai)
#pragma unroll
            for (int m = 0; m < 4; ++m)
#pragma unroll
                for (int bj = 0; bj < 2; ++bj) { const size_t off = (size_t)(row0 + ai * 128 + m * 16) * DM + col0 + bj * 128;
                    const pg8::u32x4 sg = *(const pg8::u32x4*)(SG + off);
                    pg8::f32x4 v0 = acc[ai][bj][m][0], v1 = acc[ai][bj][m][1];
                    v0[0] *= bflo(sg.x); v0[1] *= bfhi(sg.x); v0[2] *= bflo(sg.y); v0[3] *= bfhi(sg.y);
                    v1[0] *= bflo(sg.z); v1[1] *= bfhi(sg.z); v1[2] *= bflo(sg.w); v1[3] *= bfhi(sg.w);
                    if (which == 0) { *(pg8::f32x4*)(T + off) = v0; *(pg8::f32x4*)(T + off + 4) = v1; }
                    else { const pg8::f32x4 t0 = *(const pg8::f32x4*)(T + off), t1 = *(const pg8::f32x4*)(T + off + 4); v0 += t0; v1 += t1;
                        pg8::u32x4 w; w.x = pg8::cvt_pk_bf16(v0[0], v0[1]); w.y = pg8::cvt_pk_bf16(v0[2], v0[3]); w.z = pg8::cvt_pk_bf16(v1[0], v1[1]); w.w = pg8::cvt_pk_bf16(v1[2], v1[3]);
                        *(pg8::u32x4*)(Y1 + off) = w; } }
    }
};
struct EpiY {
    static constexpr bool PERM = false, AFTER_DRAIN = false;
    unsigned char* ws;
    __device__ __forceinline__ void operator()(const acc_t& acc, const pg8::Unit& u, int wr, int wc, int fr, int fq) const {
        float* Y = (float*)(ws + WS_Y); float* SSQ = (float*)(ws + WS_SSQ);
        const int row0 = u.pm * 256 + wr * 64 + fr, col0 = u.pn * 256 + wc * 32 + 4 * fq;
#pragma unroll
        for (int ai = 0; ai < 2; ++ai)
#pragma unroll
            for (int m = 0; m < 4; ++m) { const int row = row0 + ai * 128 + m * 16; float ss = 0.f;
#pragma unroll
                for (int bj = 0; bj < 2; ++bj)
#pragma unroll
                    for (int n = 0; n < 2; ++n) { const pg8::f32x4 v = acc[ai][bj][m][n]; *(pg8::f32x4*)(Y + (size_t)row * DM + col0 + bj * 128 + n * 16) = v;
                        ss += (v[0] * v[0] + v[1] * v[1]) + (v[2] * v[2] + v[3] * v[3]); }
                ss += __shfl_xor(ss, 16); ss += __shfl_xor(ss, 32);
                if (fq == 0) SSQ[(size_t)row * 32 + u.pn * 4 + wc] = ss; }
    }
};
struct EpiGU {
    static constexpr bool PERM = true, AFTER_DRAIN = false;
    unsigned char* ws;
    __device__ __forceinline__ void operator()(const acc_t& acc, const pg8::Unit& u, int wr, int wc, int fr, int fq) const {
        bf16* ACT = (bf16*)(ws + WS_ACT);
        const int row0 = u.pm * 256 + wr * 64 + fr, col0 = (u.pn & 3) * 128 + wc * 32 + 8 * fq;
#pragma unroll
        for (int ai = 0; ai < 2; ++ai)
#pragma unroll
            for (int m = 0; m < 4; ++m) { float a[8];
#pragma unroll
                for (int n = 0; n < 2; ++n)
#pragma unroll
                    for (int i = 0; i < 4; ++i) { const float gv = acc[ai][0][m][n][i], uv = acc[ai][1][m][n][i]; a[4 * n + i] = gv * sigmoidf_(gv) * uv; }
                pg8::u32x4 w; w.x = pg8::cvt_pk_bf16(a[0], a[1]); w.y = pg8::cvt_pk_bf16(a[2], a[3]); w.z = pg8::cvt_pk_bf16(a[4], a[5]); w.w = pg8::cvt_pk_bf16(a[6], a[7]);
                *(pg8::u32x4*)(ACT + (size_t)(row0 + ai * 128 + m * 16) * DEXP + col0) = w; }
    }
};
struct EpiDown {
    static constexpr bool PERM = false, AFTER_DRAIN = false;
    unsigned char* ws;
    __device__ __forceinline__ void operator()(const acc_t& acc, const pg8::Unit& u, int wr, int wc, int fr, int fq) const {
        float* YE = (float*)(ws + WS_YE); const int2* DESC = (const int2*)(ws + WS_DESC);
        const int row0 = u.pm * 256 + wr * 64 + fr, col0 = (u.pn & 7) * 256 + wc * 32 + 4 * fq;
#pragma unroll
        for (int ai = 0; ai < 2; ++ai)
#pragma unroll
            for (int m = 0; m < 4; ++m) { const int2 d = DESC[row0 + ai * 128 + m * 16]; const float w = __int_as_float(d.y);
                if (d.x >= 0) {
#pragma unroll
                    for (int bj = 0; bj < 2; ++bj)
#pragma unroll
                        for (int n = 0; n < 2; ++n) *(pg8::f32x4*)(YE + (size_t)d.x * DM + col0 + bj * 128 + n * 16) = acc[ai][bj][m][n] * w; } }
    }
};

struct GateOrder {
    pg8::StaticOrder so;
    __device__ void init(int G, int c) { so.init(S, DM, G, c); }
    __device__ bool next(int i, pg8::Unit& u) const {
        const int rounds = (so.nwg + so.G - 1) / so.G;
        const int which = i & 1, ti = i >> 1; if (ti >= rounds) return false;
        pg8::Unit t; if (!so.next(ti, t)) return false;
        u.pm = t.pm + 32 * which; u.pn = t.pn + 8 * which; return true;
    }
    __device__ __forceinline__ void a_ready(const pg8::Unit&) const {}
    __device__ __forceinline__ void done(const pg8::Unit&) const {}
};
struct MoeOrder {
    const volatile LAS int* mts; int shift, G, v;
    __device__ bool next(int i, pg8::Unit& u) const {
        const int total = mts[32] << shift; const int L = i * G + v; if (L >= total) return false;
        const int mt = L >> shift, pn = L & ((1 << shift) - 1); int e = 0;
        for (int j = 1; j < 32; ++j) e += (mts[j] <= mt) ? 1 : 0;
        u.pm = mt; u.pn = (e << shift) | pn; return true;
    }
    __device__ __forceinline__ void a_ready(const pg8::Unit&) const {}
    __device__ __forceinline__ void done(const pg8::Unit&) const {}
};
__device__ __forceinline__ void build_mts(Ctx& F) {
    volatile LAS int* mts = (volatile LAS int*)(F.lds + LDSCTL_OFF) + 64;
    __syncthreads();
    if (F.tid == 0) { const gu32* cnt = (const gu32*)(F.ws + WS_CTL) + CW_CNT; int acc = 0;
        for (int e = 0; e < 32; ++e) { mts[e] = acc; const int c = (int)__hip_atomic_load(cnt + e, RLX_AGENT); acc += (c + 255) >> 8; }
        mts[32] = acc; }
    __syncthreads();
}

__device__ __forceinline__ void phase3(Ctx& F) {
    const int gw = F.vcu * NWAVES + F.wave, NGW = F.G * NWAVES, lane = F.lane;
    const bf16* KA = (const bf16*)(F.ws + WS_KA); float* KM = (float*)(F.ws + WS_KMEAN);
    for (int it = gw; it < 16 * 32; it += NGW) { const int h = it >> 5, j = it & 31; float s = 0.f;
        const bf16* p = KA + (size_t)(256 * j) * 1024 + 64 * h + lane;
#pragma unroll 8
        for (int r = 0; r < 256; ++r) s += bf2f(p[(size_t)r * 1024]);
        KM[(size_t)it * 64 + lane] = s * (1.0f / 256.0f); }
}

__device__ __forceinline__ void attn_naive(Ctx& F) {
    const int gw = F.vcu * NWAVES + F.wave, NGW = F.G * NWAVES, lane = F.lane;
    LAS float* wscr = (LAS float*)(F.lds + RING_OFF) + F.wave * 1280;
    LAS float* qs = wscr + 1024; LAS float* gsb = wscr + 1088;
    const bf16* QA = (const bf16*)(F.ws + WS_QA); const bf16* KA = (const bf16*)(F.ws + WS_KA); const bf16* VA = (const bf16*)(F.ws + WS_VA);
    const bf16* QB = (const bf16*)(F.ws + WS_QB); const bf16* KB = (const bf16*)(F.ws + WS_KB); const bf16* VB = (const bf16*)(F.ws + WS_VB);
    const float* KM = (const float*)(F.ws + WS_KMEAN);
    bf16* OA = (bf16*)(F.ws + WS_OAB); bf16* OB = OA + (size_t)S * 1024;
    const float NEG = -INFINITY;
    for (int it = gw; it < 2 * S * NH; it += NGW) {
        const int mode = it / (S * NH), rem = it % (S * NH), t = rem >> 4, h = rem & 15;
        const float slope2 = exp2f(-0.5f * (float)(h + 1)) * LOG2E;
        if (mode == 0) {
            const int blk = t >> 8;
            qs[lane] = bf2f(QA[(size_t)t * 1024 + 64 * h + lane]);
            LDS_WAIT(); asm volatile("" ::: "memory");
            float g = NEG;
            if (lane < blk) { g = 0.f; const float* kmp = KM + (size_t)(h * 32 + lane) * 64; for (int d = 0; d < 64; ++d) g += qs[d] * kmp[d]; }
            if (lane < 32) gsb[lane] = g;
            LDS_WAIT(); asm volatile("" ::: "memory");
            float b0 = NEG, b1 = NEG, b2 = NEG; int i0 = -1, i1 = -1, i2 = -1;
            for (int j = 0; j < blk; ++j) { const float v = gsb[j];
                if (v > b0) { b2 = b1; i2 = i1; b1 = b0; i1 = i0; b0 = v; i0 = j; }
                else if (v > b1) { b2 = b1; i2 = i1; b1 = v; i1 = j; }
                else if (v > b2) { b2 = v; i2 = j; } }
            float mx = NEG; int nk = 0;
            for (int seg = 0; seg < 4; ++seg) { const int bj = seg == 0 ? i0 : seg == 1 ? i1 : seg == 2 ? i2 : blk; if (bj < 0) continue;
                const int nkeys = (seg == 3) ? (t & 255) + 1 : 256;
                for (int k0 = 0; k0 < nkeys; k0 += 64) { const int key = k0 + lane;
                    if (key < nkeys) { const int kp = bj * 256 + key; const GAS v4u* kr = (const GAS v4u*)(KA + (size_t)kp * 1024 + 64 * h); float s = 0.f;
#pragma unroll
                        for (int d8 = 0; d8 < 8; ++d8) { const v4u kv = kr[d8]; const LAS float* q8 = qs + 8 * d8;
                            s += q8[0] * bflo(kv.x) + q8[1] * bfhi(kv.x) + q8[2] * bflo(kv.y) + q8[3] * bfhi(kv.y) + q8[4] * bflo(kv.z) + q8[5] * bfhi(kv.z) + q8[6] * bflo(kv.w) + q8[7] * bfhi(kv.w); }
                        s += slope2 * (float)(kp - t); wscr[nk + key] = s; mx = fmaxf(mx, s); } }
                nk += nkeys; }
            mx = wave_max(mx);
            LDS_WAIT(); asm volatile("" ::: "memory");
            float l = 0.f, o = 0.f; int idx = 0;
            for (int seg = 0; seg < 4; ++seg) { const int bj = seg == 0 ? i0 : seg == 1 ? i1 : seg == 2 ? i2 : blk; if (bj < 0) continue;
                const int nkeys = (seg == 3) ? (t & 255) + 1 : 256;
                const bf16* vr = VA + (size_t)(bj * 256) * 1024 + 64 * h + lane;
                for (int key = 0; key < nkeys; ++key) { const float p = exp2f(wscr[idx + key] - mx); l += p; o += p * bf2f(vr[(size_t)key * 1024]); }
                idx += nkeys; }
            OA[(size_t)t * 1024 + 64 * h + lane] = (bf16)f2bf(o / l);
            LDS_WAIT(); asm volatile("" ::: "memory");
        } else {
            const int hkv = h >> 2; const float sink2 = F.in[I_SINKS][h] * LOG2E;
            qs[lane] = bf2f(QB[(size_t)t * 1024 + 64 * h + lane]);
            LDS_WAIT(); asm volatile("" ::: "memory");
            const int kp0 = t - 127 > 0 ? t - 127 : 0, nkeys = t - kp0 + 1;
            float mx = NEG;
            for (int k0 = 0; k0 < nkeys; k0 += 64) { const int key = k0 + lane;
                if (key < nkeys) { const int kp = kp0 + key; const GAS v4u* kr = (const GAS v4u*)(KB + (size_t)kp * 256 + 64 * hkv); float s = 0.f;
#pragma unroll
                    for (int d8 = 0; d8 < 8; ++d8) { const v4u kv = kr[d8]; const LAS float* q8 = qs + 8 * d8;
                        s += q8[0] * bflo(kv.x) + q8[1] * bfhi(kv.x) + q8[2] * bflo(kv.y) + q8[3] * bfhi(kv.y) + q8[4] * bflo(kv.z) + q8[5] * bfhi(kv.z) + q8[6] * bflo(kv.w) + q8[7] * bfhi(kv.w); }
                    s += slope2 * (float)(kp - t); wscr[key] = s; mx = fmaxf(mx, s); } }
            mx = wave_max(mx);
            LDS_WAIT(); asm volatile("" ::: "memory");
            float l = exp2f(sink2 - mx), o = 0.f;
            const bf16* vr = VB + (size_t)kp0 * 256 + 64 * hkv + lane;
            for (int key = 0; key < nkeys; ++key) { const float p = exp2f(wscr[key] - mx); l += p; o += p * bf2f(vr[(size_t)key * 256]); }
            OB[(size_t)t * 1024 + 64 * h + lane] = (bf16)f2bf(o / l);
            LDS_WAIT(); asm volatile("" ::: "memory");
        }
    }
}

__device__ __forceinline__ void phase7(Ctx& F) {
    LAS float* gm = (LAS float*)(F.lds + RING_OFF);
    LAS float* gsf = gm + DM;
    LAS float* shf = gsf + DM;
    const float* MOD = (const float*)(F.ws + WS_MOD);
    for (int n = F.tid; n < DM; n += NTHREADS) { gm[n] = MOD[2 * DM + n] * F.in[I_GPOST][n]; gsf[n] = F.in[I_GPREF][n] * (1.0f + MOD[4 * DM + n]); shf[n] = MOD[3 * DM + n]; }
    __syncthreads();
    const int gw = F.vcu * NWAVES + F.wave, NGW = F.G * NWAVES, lane = F.lane;
    const float* Y = (const float*)(F.ws + WS_Y); const float* SSQ = (const float*)(F.ws + WS_SSQ); const float* WRT = (const float*)(F.ws + WS_WRT);
    bf16* XN = (bf16*)(F.ws + WS_XN); float* EW = (float*)(F.ws + WS_EW); int* LIST = (int*)(F.ws + WS_LIST);
    gu32* CNT = (gu32*)(F.ws + WS_CTL) + CW_CNT;
    constexpr int R = 2;
    for (int m0 = gw * R; m0 < S; m0 += NGW * R) {
        f32x4 h[R][8];
#pragma unroll
        for (int r = 0; r < R; ++r) { const int m = m0 + r;
            const float ssq = wave_sum(lane < 32 ? SSQ[(size_t)m * 32 + lane] : 0.f);
            const float rstdy = 1.0f / sqrtf(ssq * (1.0f / DM) + RMS_EPS);
            const GAS f32x4* yr = (const GAS f32x4*)(Y + (size_t)m * DM) + lane; const GAS f32x4* xr = (const GAS f32x4*)(F.in[I_X] + (size_t)m * DM) + lane;
            GAS f32x4* xo = (GAS f32x4*)(F.out + (size_t)m * DM) + lane; float s2 = 0.f;
#pragma unroll
            for (int j = 0; j < 8; ++j) { const int d = 4 * lane + 256 * j; const f32x4 g4 = *(const LAS f32x4*)(gm + d);
                const f32x4 xm = xr[64 * j] + g4 * (yr[64 * j] * rstdy); xo[64 * j] = xm; h[r][j] = xm;
                s2 += (xm.x * xm.x + xm.y * xm.y) + (xm.z * xm.z + xm.w * xm.w); }
            const float rstd2 = 1.0f / sqrtf(wave_sum(s2) * (1.0f / DM) + RMS_EPS);
            GAS unsigned long long* o8 = (GAS unsigned long long*)(XN + (size_t)m * DM) + lane;
#pragma unroll
            for (int j = 0; j < 8; ++j) { const int d = 4 * lane + 256 * j; const f32x4 g4 = *(const LAS f32x4*)(gsf + d), s4 = *(const LAS f32x4*)(shf + d);
                const f32x4 hv = h[r][j] * rstd2 * g4 + s4; h[r][j] = hv;
                o8[64 * j] = (unsigned long long)pk2(hv.x, hv.y) | ((unsigned long long)pk2(hv.z, hv.w) << 32); }
            asm volatile("" ::: "memory");
        }
        float lg[R];
#pragma unroll
        for (int r = 0; r < R; ++r) lg[r] = 0.f;
#pragma unroll 1
        for (int o = 0; o < 36; ++o) {
            const GAS f32x4* wr_ = (const GAS f32x4*)(WRT + (size_t)o * DM) + lane;
            float p[R];
#pragma unroll
            for (int r = 0; r < R; ++r) p[r] = 0.f;
#pragma unroll
            for (int j = 0; j < 8; ++j) { const f32x4 w = wr_[64 * j];
#pragma unroll
                for (int r = 0; r < R; ++r) p[r] += (h[r][j].x * w.x + h[r][j].y * w.y) + (h[r][j].z * w.z + h[r][j].w * w.w); }
            const float bias = (o < 4) ? F.in[I_BRG][o] : F.in[I_BRE][o - 4];
#pragma unroll
            for (int r = 0; r < R; ++r) { const float t = wave_sum(p[r]) + bias; lg[r] = (lane == o) ? t : lg[r]; }
        }
#pragma unroll
        for (int r = 0; r < R; ++r) { const int m = m0 + r;
            const float g0 = __shfl(lg[r], 0), g1 = __shfl(lg[r], 1), g2 = __shfl(lg[r], 2), g3 = __shfl(lg[r], 3);
            int gsel = 0; float gmax = g0;
            if (g1 > gmax) { gmax = g1; gsel = 1; } if (g2 > gmax) { gmax = g2; gsel = 2; } if (g3 > gmax) { gmax = g3; gsel = 3; }
            const float gw_ = 1.0f / (expf(g0 - gmax) + expf(g1 - gmax) + expf(g2 - gmax) + expf(g3 - gmax));
            float t0 = -INFINITY, t1 = -INFINITY; int j0 = 0, j1 = 0;
#pragma unroll
            for (int i = 0; i < 8; ++i) { const float v = __shfl(lg[r], 4 + 8 * gsel + i);
                if (v > t0) { t1 = t0; j1 = j0; t0 = v; j0 = i; } else if (v > t1) { t1 = v; j1 = i; } }
            const float e1 = expf(t1 - t0), w0 = gw_ / (1.0f + e1), w1 = gw_ * e1 / (1.0f + e1);
            if (lane == 0) {
                const int ea = gsel * 8 + j0, eb = gsel * 8 + j1;
                const int pa = (int)__hip_atomic_fetch_add(CNT + ea, 1u, RLX_AGENT), pb = (int)__hip_atomic_fetch_add(CNT + eb, 1u, RLX_AGENT);
                LIST[ea * S + pa] = 2 * m; LIST[eb * S + pb] = 2 * m + 1; EW[2 * m] = w0; EW[2 * m + 1] = w1; }
        }
    }
    __syncthreads();
}

__device__ __forceinline__ void phase8(Ctx& F) {
    build_mts(F);
    volatile LAS int* mts = (volatile LAS int*)(F.lds + LDSCTL_OFF) + 64;
    const int gw = F.vcu * NWAVES + F.wave, NGW = F.G * NWAVES, lane = F.lane;
    const int total = mts[32] * 256;
    const bf16* XN = (const bf16*)(F.ws + WS_XN); bf16* XG = (bf16*)(F.ws + WS_XG); const float* EW = (const float*)(F.ws + WS_EW); const int* LIST = (const int*)(F.ws + WS_LIST);
    int2* DESC = (int2*)(F.ws + WS_DESC); const gu32* CNT = (const gu32*)(F.ws + WS_CTL) + CW_CNT;
    for (int row = gw; row < total; row += NGW) {
        const int mt = row >> 8; int e = 0;
        for (int j = 1; j < 32; ++j) e += (mts[j] <= mt) ? 1 : 0;
        const int pos = row - 256 * mts[e]; const int cnt = (int)__hip_atomic_load(CNT + e, RLX_AGENT);
        GAS v4u* dst = (GAS v4u*)(XG + (size_t)row * DM) + lane;
        if (pos < cnt) { const int ent = LIST[e * S + pos]; const GAS v4u* src = (const GAS v4u*)(XN + (size_t)(ent >> 1) * DM) + lane;
#pragma unroll
            for (int i = 0; i < 4; ++i) dst[64 * i] = src[64 * i];
            if (lane == 0) DESC[row] = make_int2(ent, __float_as_int(EW[ent])); }
        else {
#pragma unroll
            for (int i = 0; i < 4; ++i) dst[64 * i] = (v4u){0u, 0u, 0u, 0u};
            if (lane == 0) DESC[row] = make_int2(-1, 0); }
    }
}

__device__ __forceinline__ void phase11(Ctx& F) {
    LAS float* gf = (LAS float*)(F.lds + RING_OFF);
    const float* MOD = (const float*)(F.ws + WS_MOD);
    for (int n = F.tid; n < DM; n += NTHREADS) gf[n] = MOD[5 * DM + n] * F.in[I_GPOSTF][n];
    __syncthreads();
    const int gw = F.vcu * NWAVES + F.wave, NGW = F.G * NWAVES, lane = F.lane;
    const float* YE = (const float*)(F.ws + WS_YE);
    for (int m = gw; m < S; m += NGW) {
        const GAS f32x4* a = (const GAS f32x4*)(YE + (size_t)(2 * m) * DM) + lane; const GAS f32x4* b = (const GAS f32x4*)(YE + (size_t)(2 * m + 1) * DM) + lane;
        GAS f32x4* xo = (GAS f32x4*)(F.out + (size_t)m * DM) + lane;
        f32x4 v[8]; float s2 = 0.f;
#pragma unroll
        for (int j = 0; j < 8; ++j) { v[j] = a[64 * j] + b[64 * j]; s2 += (v[j].x * v[j].x + v[j].y * v[j].y) + (v[j].z * v[j].z + v[j].w * v[j].w); }
        const float rstd = 1.0f / sqrtf(wave_sum(s2) * (1.0f / DM) + RMS_EPS);
#pragma unroll
        for (int j = 0; j < 8; ++j) { const int d = 4 * lane + 256 * j; const f32x4 g4 = *(const LAS f32x4*)(gf + d); xo[64 * j] = xo[64 * j] + g4 * (v[j] * rstd); }
    }
    __syncthreads();
}

struct Args { const float* in[20]; float* out; unsigned char* ws; int ph_lo, ph_hi, li, pad; };
__global__ void __launch_bounds__(NTHREADS, 2) mega_fwd(Args args) {
    extern __shared__ __attribute__((aligned(16))) unsigned char lds[];
    Ctx F;
#pragma unroll
    for (int i = 0; i < 20; ++i) F.in[i] = args.in[i];
    F.out = args.out; F.ws = args.ws;
    F.lds = (LAS unsigned char*)lds;
    F.tid = threadIdx.x; F.lane = F.tid & 63; F.wave = __builtin_amdgcn_readfirstlane(F.tid >> 6);
    F.G = gridDim.x; { const int bx = blockIdx.x; F.vcu = (F.G % 8 == 0) ? (bx % 8) * (F.G / 8) + bx / 8 : bx; }
    volatile LAS unsigned* MISC = (volatile LAS unsigned*)(F.lds + LDSCTL_OFF);
    for (int u = F.tid; u < 256; u += NTHREADS) MISC[u] = 0u;
    __syncthreads();
    gu32* ctl = (gu32*)(F.ws + WS_CTL);
    XcdBarrier bar; bar.bar = (unsigned*)(ctl + CW_BAR); bar.x = 0; bar.st = nullptr;
    if (N_LAUNCHES != PER_PHASE) bar = xcd_barrier_post((unsigned*)(ctl + CW_BAR), MISC + 8);
    const int lo = args.ph_lo, hi = args.ph_hi;
#ifndef PH_MASK
#define PH_MASK 0xfff
#endif
#define IN(k) (((PH_MASK >> (k)) & 1) && lo <= (k) && (k) < hi)
#define SEAM(k) do { if (IN(k) && IN((k) + 1)) xcd_barrier(bar); } while (0)
    unsigned char* ws = F.ws;
    if (IN(0)) { phase0(F); SEAM(0); }
    if (IN(1)) { phase1(F); SEAM(1); }
    if (IN(2)) { pg8::Gemm g{(const pg8::bf16_t*)(ws + WS_XN), (const pg8::bf16_t*)(ws + WS_WT_IN), S, NIN, DM}; pg8::StaticOrder so; so.init(S, NIN, F.G, (int)blockIdx.x);
        EpiQKVG E{ws}; run_gemm(F, g, so, E); SEAM(2); }
    if (IN(3)) { phase3(F); SEAM(3); }
    if (IN(4)) { attn_naive(F); SEAM(4); }
    if (IN(5)) { pg8::Gemm g{(const pg8::bf16_t*)(ws + WS_OAB), (const pg8::bf16_t*)(ws + WS_WT_OAB), 2 * S, 2 * DM, 1024}; GateOrder go; go.init(F.G, (int)blockIdx.x);
        EpiGate E{ws}; run_gemm(F, g, go, E); SEAM(5); }
    if (IN(6)) { pg8::Gemm g{(const pg8::bf16_t*)(ws + WS_Y1), (const pg8::bf16_t*)(ws + WS_WT_OUT), S, DM, DM}; pg8::StaticOrder so; so.init(S, DM, F.G, (int)blockIdx.x);
        EpiY E{ws}; run_gemm(F, g, so, E); SEAM(6); }
    if (IN(7)) { phase7(F); SEAM(7); }
    if (IN(8)) { phase8(F); SEAM(8); }
    if (IN(9)) { build_mts(F); pg8::Gemm g{(const pg8::bf16_t*)(ws + WS_XG), (const pg8::bf16_t*)(ws + WS_WT_GU), MAXROWS, NEXP * 1024, DM};
        MoeOrder mo{(const volatile LAS int*)(F.lds + LDSCTL_OFF) + 64, 2, F.G, F.vcu}; EpiGU E{ws}; run_gemm(F, g, mo, E); SEAM(9); }
    if (IN(10)) { build_mts(F); pg8::Gemm g{(const pg8::bf16_t*)(ws + WS_ACT), (const pg8::bf16_t*)(ws + WS_WT_D), MAXROWS, NEXP * DM, DEXP};
        MoeOrder mo{(const volatile LAS int*)(F.lds + LDSCTL_OFF) + 64, 3, F.G, F.vcu}; EpiDown E{ws}; run_gemm(F, g, mo, E); SEAM(10); }
    if (IN(11)) { phase11(F); }
#undef IN
#undef SEAM
}

extern "C" void kernel_launch(void* const* d_in, const int* in_sizes, int n_in, void* d_out, int out_size, void* d_ws, size_t ws_size, hipStream_t stream) {
    static int grid = 0;
    if (grid == 0) {
        if (n_in != 20 || out_size != S * DM || ws_size < WS_END) { fprintf(stderr, "kernel_launch: unexpected shapes: n_in %d out %d ws %zu (need %zu)\n", n_in, out_size, ws_size, (size_t)WS_END); grid = -1; return; }
        int dev = 0, cus = 0, per_cu = 0;
        if (hipGetDevice(&dev) != hipSuccess || hipDeviceGetAttribute(&cus, hipDeviceAttributeMultiprocessorCount, dev) != hipSuccess) { fprintf(stderr, "kernel_launch: device query failed\n"); grid = -1; return; }
        if (hipFuncSetAttribute((const void*)mega_fwd, hipFuncAttributeMaxDynamicSharedMemorySize, LDS_BYTES) != hipSuccess) { fprintf(stderr, "kernel_launch: hipFuncSetAttribute failed\n"); grid = -1; return; }
        if (hipOccupancyMaxActiveBlocksPerMultiprocessor(&per_cu, (const void*)mega_fwd, NTHREADS, LDS_BYTES) != hipSuccess || per_cu < 1) { fprintf(stderr, "kernel_launch: occupancy query says %d blocks per CU\n", per_cu); grid = -1; (void)hipGetLastError(); return; }
        grid = cus;
        fprintf(stderr, "kernel_launch: grid %d (occupancy query: %d per CU)\n", grid, per_cu);
    }
    if (grid < 0) return;
    if (hipMemsetAsync((char*)d_ws + WS_CTL, 0, CTL_ZERO_BYTES, stream) != hipSuccess) { fprintf(stderr, "kernel_launch: memset failed\n"); return; }
    Args a{};
    for (int i = 0; i < 20; ++i) a.in[i] = (const float*)d_in[i];
    a.out = (float*)d_out; a.ws = (unsigned char*)d_ws;
    if (N_LAUNCHES == 1) {
        a.ph_lo = 0; a.ph_hi = PER_PHASE; a.li = 0;
        void* kargs[] = {&a};
        hipError_t e = hipLaunchCooperativeKernel((const void*)mega_fwd, dim3(grid), dim3(NTHREADS), kargs, LDS_BYTES, stream);
        if (e != hipSuccess) fprintf(stderr, "kernel_launch: cooperative launch failed: %s (grid %d)\n", hipGetErrorString(e), grid);
    } else {
        for (int li = 0; li < PER_PHASE; ++li) { a.ph_lo = li; a.ph_hi = li + 1; a.li = li;
            hipLaunchKernelGGL(mega_fwd, dim3(grid), dim3(NTHREADS), LDS_BYTES, stream, a);
            const hipError_t le = hipPeekAtLastError(); if (le != hipSuccess) { fprintf(stderr, "kernel_launch: launch %d failed: %s\n", li, hipGetErrorName(le)); break; } }
    }
}
```

```cpp
#include <hip/hip_runtime.h>
#include <cstdio>
#include <cstdint>
#include <cmath>

#ifndef MK_N_LAUNCHES
#define MK_N_LAUNCHES 1
#endif
#ifndef FAST_GEMM
#define FAST_GEMM 1
#endif
#ifndef FAST_ATTN
#define FAST_ATTN 1
#endif
namespace pg8 {
#define PG8_LAS __attribute__((address_space(3)))
typedef unsigned short bf16_t;
typedef short bf16x8 __attribute__((ext_vector_type(8)));
typedef float f32x4 __attribute__((ext_vector_type(4)));
typedef unsigned u32x4 __attribute__((ext_vector_type(4)));
constexpr int BM = 256, BK = 64, HALF = 128, HTB = HALF * BK * 2  , STAGE_BYTES = 8 * HTB, NXCD = 8, WGM = 8;

__host__ __device__ __forceinline__ int lds_byte(int r, int c) { const int st = (r >> 4) * 2 + (c >> 5), rr = r & 15, cc = c & 31, ob = rr * 64 + cc * 2; return st * 1024 + (ob ^ (((ob >> 9) & 1) << 5)); }
__host__ __device__ __forceinline__ void stage_rc(int b, int& R, int& C) { const int st = b / 1024, sb = b % 1024, swz = sb ^ (((sb >> 9) & 1) << 5); R = (st >> 1) * 16 + swz / 64; C = (st & 1) * 32 + (swz % 64) / 2; }
__host__ __device__ __forceinline__ int perm32(int rho) { const int n = rho >> 4, i = rho & 15; return 8 * (i >> 2) + 4 * n + (i & 3); }

struct Unit { int pm, pn; };
struct Gemm { const bf16_t* A; const bf16_t* Bt; int M, N, K; };

struct StaticOrder {
    int nM, nN, nwg, G, c;
    __host__ __device__ void init(int M, int N, int G_, int c_) { nM = M / BM; nN = N / BM; nwg = nM * nN; G = G_; c = c_; }
    __host__ __device__ bool next(int i, Unit& u) const {
        const long L = (long)i * G + c; if (L >= nwg) return false;
        int wgid = (int)L; { const int q = nwg / NXCD, r = nwg % NXCD, xcd = wgid % NXCD, off = wgid / NXCD; wgid = (xcd < r ? xcd * (q + 1) : r * (q + 1) + (xcd - r) * q) + off; }
        const int nig = WGM * nN, gid = wgid / nig, fm = gid * WGM, gsz = (nM - fm) < WGM ? (nM - fm) : WGM;
        u.pm = fm + ((wgid % nig) % gsz); u.pn = (wgid % nig) / gsz; return true;
    }
    __device__ __forceinline__ void a_ready(const Unit&) const {}
    __device__ __forceinline__ void done(const Unit&) const {}
};

__device__ __forceinline__ unsigned cvt_pk_bf16(float lo, float hi) { unsigned r; asm volatile("v_cvt_pk_bf16_f32 %0, %1, %2" : "=v"(r) : "v"(lo), "v"(hi)); return r; }
template <class Epi, class Sched, bool ALIGN_EPI = false, bool SP2 = false>
__device__ __forceinline__ void gemm_phase(PG8_LAS unsigned char* lds, const Gemm g, const Sched& S, const Epi& E) {
    const int tid = threadIdx.x, wid = __builtin_amdgcn_readfirstlane(tid >> 6), lane = tid & 63, wr = wid >> 2, wc = wid & 3, fr = lane & 15, fq = lane >> 4;
    const int K = g.K, nt = K / BK;
    unsigned voffA[2], voffB[2];
#pragma unroll
    for (int i = 0; i < 2; ++i) { int R, C; stage_rc(tid * 16 + i * 8192, R, C); const int Rb = Epi::PERM ? ((R & ~31) + perm32(R & 31)) : R;
        voffA[i] = (unsigned)(R * K + C) * 2u; voffB[i] = (unsigned)(Rb * K + C) * 2u; }
    const size_t kstep = (size_t)(BK * 2);
    const size_t hstep = (size_t)HALF * K * 2;
    const size_t tstep = 2 * hstep;
    const unsigned ldsw = (unsigned)wid * 1024u;
    const int aoff = lds_byte(wr * 64 + fr, fq * 8), boff = lds_byte(wc * 32 + fr, fq * 8);
#define PG8_SA(b, h) (((b) * 2 + (h)) * HTB)
#define PG8_SB(b, h) ((4 + (b) * 2 + (h)) * HTB)
#define PG8_STAGE(bufoff, gbase, voff) do { _Pragma("unroll") for (int _i = 0; _i < 2; ++_i) \
        __builtin_amdgcn_global_load_lds((const unsigned*)((const char*)(gbase) + (voff)[_i]), (PG8_LAS unsigned*)(lds + (bufoff) + ldsw + _i * 8192), 16, 0, 0); } while (0)
#define PG8_LDA(dst, b, h) do { _Pragma("unroll") for (int m = 0; m < 4; ++m) _Pragma("unroll") for (int k = 0; k < 2; ++k) dst[m][k] = *(const PG8_LAS bf16x8*)(lds + PG8_SA(b, h) + aoff + m * 2048 + k * 1024); } while (0)
#define PG8_LDB(dst, b, h) do { _Pragma("unroll") for (int n = 0; n < 2; ++n) _Pragma("unroll") for (int k = 0; k < 2; ++k) dst[n][k] = *(const PG8_LAS bf16x8*)(lds + PG8_SB(b, h) + boff + n * 2048 + k * 1024); } while (0)
#define PG8_MMA(ai, bj, At, Bt) do { __builtin_amdgcn_s_setprio(1); _Pragma("unroll") for (int m = 0; m < 4; ++m) _Pragma("unroll") for (int n = 0; n < 2; ++n) _Pragma("unroll") for (int k = 0; k < 2; ++k) \
        acc[ai][bj][m][n] = __builtin_amdgcn_mfma_f32_16x16x32_bf16(Bt[n][k], At[m][k], acc[ai][bj][m][n], 0, 0, 0); __builtin_amdgcn_s_setprio(0); } while (0)
#define PG8_WAIT_V(n) asm volatile("s_waitcnt vmcnt(" #n ")" ::: "memory")
#define PG8_WAIT_L(n) asm volatile("s_waitcnt lgkmcnt(" #n ")" ::: "memory")
#define PG8_BAR __builtin_amdgcn_s_barrier()
#define PG8_SCHED __builtin_amdgcn_sched_barrier(0)
    Unit cur, nxt; int ui = 0;
    if (!S.next(0, cur)) return;
    f32x4 acc[2][2][4][2];
#pragma unroll
    for (int a = 0; a < 2; ++a)
#pragma unroll
        for (int b = 0; b < 2; ++b)
#pragma unroll
            for (int m = 0; m < 4; ++m)
#pragma unroll
                for (int n = 0; n < 2; ++n) acc[a][b][m][n] = (f32x4){0.f, 0.f, 0.f, 0.f};
    bf16x8 At[4][2], B0[2][2], B1[2][2];
    const char* cA = (const char*)g.A + (size_t)cur.pm * tstep; const char* cB = (const char*)g.Bt + (size_t)cur.pn * tstep;
    S.a_ready(cur);
    if constexpr (SP2) {
        PG8_STAGE(PG8_SB(0, 0), cB, voffB); PG8_STAGE(PG8_SB(0, 1), cB + hstep, voffB); PG8_STAGE(PG8_SA(0, 0), cA, voffA); PG8_STAGE(PG8_SA(0, 1), cA + hstep, voffA);
        if (wr == 1) PG8_BAR;
        PG8_WAIT_V(2); PG8_BAR;
        PG8_STAGE(PG8_SB(1, 0), cB + kstep, voffB); PG8_STAGE(PG8_SA(1, 0), cA + kstep, voffA); PG8_STAGE(PG8_SB(1, 1), cB + hstep + kstep, voffB);
        PG8_WAIT_V(6); PG8_BAR;
    } else {
        PG8_STAGE(PG8_SB(0, 0), cB, voffB); PG8_STAGE(PG8_SA(0, 0), cA, voffA); PG8_STAGE(PG8_SB(0, 1), cB + hstep, voffB); PG8_STAGE(PG8_SA(0, 1), cA + hstep, voffA);
        if (wr == 1) PG8_BAR;
        PG8_WAIT_V(4); PG8_BAR;
        PG8_STAGE(PG8_SB(1, 0), cB + kstep, voffB); PG8_STAGE(PG8_SA(1, 0), cA + kstep, voffA); PG8_STAGE(PG8_SB(1, 1), cB + hstep + kstep, voffB);
        PG8_WAIT_V(6); PG8_BAR;
    }
    for (;;) {
        const bool has_next = S.next(ui + 1, nxt);
        const char* nA = has_next ? (const char*)g.A + (size_t)nxt.pm * tstep : cA; const char* nB = has_next ? (const char*)g.Bt + (size_t)nxt.pn * tstep : cB;
        for (int t = 0; t < nt; t += 2) {
            const bool last = (t == nt - 2);
            const char* a1 = cA + (size_t)(t + 1) * kstep;
            const char* a2 = last ? nA : cA + (size_t)(t + 2) * kstep; const char* b2 = last ? nB : cB + (size_t)(t + 2) * kstep;
            const char* a3 = a2 + kstep; const char* b3 = b2 + kstep;
            if (last && has_next) S.a_ready(nxt);
            if constexpr (SP2) {
            PG8_LDB(B0, 0, 0); PG8_LDB(B1, 0, 1); PG8_SCHED; PG8_LDA(At, 0, 0); PG8_STAGE(PG8_SA(1, 1), a1 + hstep, voffA);
            PG8_WAIT_V(8); PG8_WAIT_L(0); PG8_BAR; PG8_MMA(0, 0, At, B0); PG8_MMA(0, 1, At, B1); PG8_BAR; PG8_SCHED;
            PG8_LDA(At, 0, 1); PG8_STAGE(PG8_SB(0, 0), b2, voffB); PG8_STAGE(PG8_SB(0, 1), b2 + hstep, voffB); PG8_STAGE(PG8_SA(0, 0), a2, voffA);
            PG8_WAIT_V(8); PG8_WAIT_L(0); PG8_BAR; PG8_MMA(1, 0, At, B0); PG8_MMA(1, 1, At, B1); PG8_BAR; PG8_SCHED;
            PG8_LDB(B0, 1, 0); PG8_LDB(B1, 1, 1); PG8_SCHED; PG8_LDA(At, 1, 0); PG8_STAGE(PG8_SA(0, 1), a2 + hstep, voffA);
            PG8_WAIT_V(8); PG8_WAIT_L(0); PG8_BAR; PG8_MMA(0, 0, At, B0); PG8_MMA(0, 1, At, B1); PG8_BAR; PG8_SCHED;
            PG8_LDA(At, 1, 1); PG8_STAGE(PG8_SB(1, 0), b3, voffB); PG8_STAGE(PG8_SB(1, 1), b3 + hstep, voffB); PG8_STAGE(PG8_SA(1, 0), a3, voffA);
            PG8_WAIT_V(8); PG8_WAIT_L(0); PG8_BAR; PG8_MMA(1, 0, At, B0); PG8_MMA(1, 1, At, B1); PG8_BAR; PG8_SCHED;
            } else {
            PG8_LDB(B0, 0, 0); PG8_SCHED; PG8_LDA(At, 0, 0); PG8_STAGE(PG8_SA(1, 1), a1 + hstep, voffA);
            PG8_WAIT_L(8); PG8_BAR; PG8_WAIT_L(0); PG8_MMA(0, 0, At, B0); PG8_BAR; PG8_SCHED;
            PG8_LDB(B1, 0, 1); PG8_STAGE(PG8_SB(0, 0), b2, voffB);
            PG8_BAR; PG8_WAIT_L(0); PG8_MMA(0, 1, At, B1); PG8_BAR;
            PG8_LDA(At, 0, 1); PG8_STAGE(PG8_SA(0, 0), a2, voffA);
            PG8_BAR; PG8_WAIT_L(0); PG8_MMA(1, 0, At, B0); PG8_BAR; PG8_SCHED;
            PG8_STAGE(PG8_SB(0, 1), b2 + hstep, voffB);
            PG8_WAIT_V(6); PG8_BAR; PG8_MMA(1, 1, At, B1); PG8_BAR;
            PG8_LDB(B0, 1, 0); PG8_SCHED; PG8_LDA(At, 1, 0); PG8_STAGE(PG8_SA(0, 1), a2 + hstep, voffA);
            PG8_WAIT_L(8); PG8_BAR; PG8_WAIT_L(0); PG8_MMA(0, 0, At, B0); PG8_BAR; PG8_SCHED;
            PG8_LDB(B1, 1, 1); PG8_STAGE(PG8_SB(1, 0), b3, voffB);
            PG8_BAR; PG8_WAIT_L(0); PG8_MMA(0, 1, At, B1); PG8_BAR;
            PG8_LDA(At, 1, 1); PG8_STAGE(PG8_SA(1, 0), a3, voffA);
            PG8_BAR; PG8_WAIT_L(0); PG8_MMA(1, 0, At, B0); PG8_BAR; PG8_SCHED;
            PG8_STAGE(PG8_SB(1, 1), b3 + hstep, voffB);
            PG8_WAIT_V(6); PG8_BAR; PG8_MMA(1, 1, At, B1); PG8_BAR;
            }
        }
        if constexpr (ALIGN_EPI) { if (wr == 0) PG8_BAR; }
        if constexpr (!Epi::AFTER_DRAIN) { E(acc, cur, wr, wc, fr, fq); S.done(cur); }
        if (!has_next) break;
#pragma unroll
        for (int a = 0; a < 2; ++a)
#pragma unroll
            for (int b = 0; b < 2; ++b)
#pragma unroll
                for (int m = 0; m < 4; ++m)
#pragma unroll
                    for (int n = 0; n < 2; ++n) acc[a][b][m][n] = (f32x4){0.f, 0.f, 0.f, 0.f};
        cur = nxt; cA = nA; cB = nB; ++ui;
        if constexpr (ALIGN_EPI) { if (wr == 1) PG8_BAR; }
    }
    PG8_WAIT_V(0);
    if constexpr (!ALIGN_EPI) { if (wr == 0) PG8_BAR; }
    PG8_BAR;
    if constexpr (Epi::AFTER_DRAIN) { E.fused(acc, cur, wr, wc, fr, fq, lds, wid, lane); S.done(cur); }
#undef PG8_SA
#undef PG8_SB
#undef PG8_STAGE
#undef PG8_LDA
#undef PG8_LDB
#undef PG8_MMA
#undef PG8_WAIT_V
#undef PG8_WAIT_L
#undef PG8_BAR
#undef PG8_SCHED
}
}
#define GAS __attribute__((address_space(1)))
#define LAS __attribute__((address_space(3)))
typedef unsigned short bf16;
typedef unsigned v4u __attribute__((ext_vector_type(4)));
typedef float f32x4 __attribute__((ext_vector_type(4)));
typedef short bf16x8 __attribute__((ext_vector_type(8)));
typedef GAS unsigned gu32;
typedef GAS unsigned long long gu64;
#define RLX_AGENT __ATOMIC_RELAXED, __HIP_MEMORY_SCOPE_AGENT
#define LDS_WAIT() asm volatile("s_waitcnt lgkmcnt(0)" ::: "memory")
#define VM_WAIT() asm volatile("s_waitcnt vmcnt(0)" ::: "memory")
__device__ __forceinline__ unsigned long long rt() { return __builtin_amdgcn_s_memrealtime(); }
__device__ __forceinline__ unsigned f2bf(float f) { unsigned u = __builtin_bit_cast(unsigned, f); return (u + 0x7fffu + ((u >> 16) & 1u)) >> 16; }
__device__ __forceinline__ unsigned pk2(float lo, float hi) { return f2bf(lo) | (f2bf(hi) << 16); }

#define XB_TMO      128
#define XB_XCNT(j)  (256  + 64 * (j))
#define XB_XSUB(j)  (1280 + 64 * (j))
#define XB_XGEN(j)  (2304 + 64 * (j))
#define XB_TOP      3328
#define XB_TOPGEN   3392
#define XCD_BAR_WORDS 3456
#define XB_SPIN_CAP (1u << 18)

__device__ __forceinline__ unsigned xb_ld(unsigned* p)              { return __hip_atomic_load(p, __ATOMIC_RELAXED, __HIP_MEMORY_SCOPE_AGENT); }
__device__ __forceinline__ unsigned xb_add(unsigned* p, unsigned v) { return __hip_atomic_fetch_add(p, v, __ATOMIC_RELAXED, __HIP_MEMORY_SCOPE_AGENT); }
__device__ __forceinline__ unsigned xb_xcc_id() { return (unsigned)__builtin_amdgcn_s_getreg((3 << 11) | 20) & 0xFu; }
#define XB_SPIN(cond, bar) do { unsigned _sp = 0; while (cond) { __builtin_amdgcn_s_sleep(1); \
    if ((++_sp & 255u) == 0u) { if (xb_ld(&(bar)[XB_TMO])) break; if (_sp > XB_SPIN_CAP) { atomicAdd(&(bar)[XB_TMO], 1u); break; } } } } while (0)

struct XcdBarrier {
    unsigned* bar; unsigned x;
    volatile LAS unsigned* st;
};

__device__ __forceinline__ XcdBarrier xcd_barrier_post(unsigned* bar, volatile LAS unsigned* st) {
    XcdBarrier b; b.bar = bar; b.x = xb_xcc_id(); b.st = st;
    if (threadIdx.x == 0) (void)xb_add(&bar[XB_XCNT(b.x)], 1u);
    return b;
}
__device__ __forceinline__ void xcd_barrier_complete(unsigned* bar, unsigned x, unsigned& nloc, unsigned& nx) {
    const unsigned G = gridDim.x * gridDim.y * gridDim.z;
    unsigned sum, cnt, mine, sp = 0u;
    for (;;) {
        sum = 0u; cnt = 0u; mine = 0u;
#pragma unroll
        for (unsigned j = 0; j < 16; ++j) { const unsigned c = xb_ld(&bar[XB_XCNT(j)]); sum += c; cnt += (c > 0u) ? 1u : 0u; mine = (j == x) ? c : mine; }
        if (sum == G) break;
        __builtin_amdgcn_s_sleep(1);
        if ((++sp & 255u) == 0u) { if (xb_ld(&bar[XB_TMO])) break; if (sp > XB_SPIN_CAP) { atomicAdd(&bar[XB_TMO], 1u); break; } }
    }
    nloc = mine > 0u ? mine : 1u; nx = cnt > 0u ? cnt : 1u;
}

__device__ __forceinline__ void xcd_barrier(const XcdBarrier& b) {
    asm volatile("s_waitcnt vmcnt(0)" ::: "memory");
    __syncthreads();
    if (threadIdx.x == 0) {
        unsigned* bar = b.bar;
        __builtin_amdgcn_s_waitcnt(0);
        unsigned nloc = b.st[0], nx = b.st[1];
        if (nloc == 0u) { xcd_barrier_complete(bar, b.x, nloc, nx); b.st[0] = nloc; b.st[1] = nx; }
        const unsigned old = xb_add(&bar[XB_XSUB(b.x)], 1u);
        const unsigned gen = old / nloc;
        if (old + 1u == (gen + 1u) * nloc) {
            __builtin_amdgcn_fence(__ATOMIC_RELEASE, "agent");
            asm volatile("s_waitcnt vmcnt(0)" ::: "memory");
            const unsigned og = xb_add(&bar[XB_TOP], 1u);
            const unsigned tg = og / nx;
            if (og + 1u == (tg + 1u) * nx) xb_add(&bar[XB_TOPGEN], 1u);
            else XB_SPIN(xb_ld(&bar[XB_TOPGEN]) == tg, bar);
            __builtin_amdgcn_fence(__ATOMIC_ACQUIRE, "agent");
            xb_add(&bar[XB_XGEN(b.x)], 1u);
            asm volatile("s_waitcnt vmcnt(0)" ::: "memory");
        } else {
            XB_SPIN(xb_ld(&bar[XB_XGEN(b.x)]) == gen, bar);
            __builtin_amdgcn_fence(__ATOMIC_ACQUIRE, "agent");
            asm volatile("s_waitcnt vmcnt(0)" ::: "memory");
        }
    }
    __syncthreads();
}

namespace att {
using bf16x8 = __attribute__((ext_vector_type(8))) short;
using s16x4 = __attribute__((ext_vector_type(4))) short;
using f32x16 = __attribute__((ext_vector_type(16))) float;
using u32x4 = __attribute__((ext_vector_type(4))) unsigned;
using f32x4 = __attribute__((ext_vector_type(4))) float;
constexpr int D = 64, NW = 8, QBLK = 32, QB = QBLK * NW, KVBLK = 64, DMQ = 1024;
constexpr int SLOTB = 8192, LDS_K = 0, LDS_V = 3 * SLOTB, LDS_WS = 6 * SLOTB, LDS_OST = LDS_WS + NW * 256, LDS_BYTES = LDS_OST + NW * 4096;
constexpr float THR = 8.0f;
#define SBAR() __builtin_amdgcn_sched_barrier(0)
#define PIN(x) asm volatile("" : "+v"(x))
#define MFMA(a, b, c) __builtin_amdgcn_mfma_f32_32x32x16_bf16(a, b, c, 0, 0, 0)
#define WAIT_BAR(N) asm volatile("s_waitcnt vmcnt(" #N ") lgkmcnt(0)\n\ts_barrier" ::: "memory")
typedef __attribute__((address_space(3))) char* lds_ptr;
typedef __attribute__((address_space(3))) const char* lds_cptr;
typedef short v4i16_t __attribute__((ext_vector_type(4)));
__device__ __forceinline__ int crow(int r, int hi) { return (r & 3) + 8 * (r >> 2) + 4 * hi; }
__device__ __forceinline__ unsigned cvtpk(float lo, float hi) { unsigned r; asm("v_cvt_pk_bf16_f32 %0, %1, %2" : "=v"(r) : "v"(lo), "v"(hi)); return r; }
__device__ __forceinline__ void glds16(const void* g, unsigned lds_base) {
    unsigned sv; asm volatile("s_mov_b32 %0, m0\n\ts_mov_b32 m0, %2\n\ts_nop 0\n\tglobal_load_lds_dwordx4 %1, off\n\ts_mov_b32 m0, %0" : "=&s"(sv) : "v"(g), "s"(lds_base) : "memory"); }
__device__ __forceinline__ void kload2(bf16x8* kf, lds_cptr kp, int d0) { kf[2 * d0] = *(const __attribute__((address_space(3))) bf16x8*)(kp + d0 * 2048); kf[2 * d0 + 1] = *(const __attribute__((address_space(3))) bf16x8*)(kp + d0 * 2048 + 512); }
__device__ __forceinline__ s16x4 vtr(lds_cptr p) { return __builtin_bit_cast(s16x4, __builtin_amdgcn_ds_read_tr16_b64_v4i16((__attribute__((address_space(3))) v4i16_t*)p)); }
#define MX3(a, b, c) __builtin_fmaxf(__builtin_fmaxf((a), (b)), (c))
__device__ __forceinline__ float rowmax(const f32x16& p0, const f32x16& p1, float c32) {
    float a = MX3(p0[0], p0[1], p0[2]), b = MX3(p1[0], p1[1], p1[2]); a = MX3(a, p0[3], p0[4]); b = MX3(b, p1[3], p1[4]);
#pragma unroll
    for (int r = 5; r < 15; r += 2) { a = MX3(a, p0[r], p0[r + 1]); b = MX3(b, p1[r], p1[r + 1]); }
    a = __builtin_fmaxf(a, p0[15]); b = __builtin_fmaxf(b, p1[15]);
    float m = __builtin_fmaxf(a, b + c32); auto rr = __builtin_amdgcn_permlane32_swap(__float_as_uint(m), __float_as_uint(m), false, false);
    return __builtin_fmaxf(__uint_as_float(rr[0]), __uint_as_float(rr[1])); }
template <int MODE> __device__ __forceinline__ void tmask(f32x16& p0, f32x16& p1, int jb, int qrel, int hi) {
    const int kb = 64 * jb + 4 * hi;
#pragma unroll
    for (int r = 0; r < 16; ++r) { const int kv = kb + (r & 3) + 8 * (r >> 2);
        if (MODE == 0) { if (kv > qrel) p0[r] = -INFINITY; if (kv + 32 > qrel) p1[r] = -INFINITY; }
        else { if (kv > qrel || kv <= qrel - 128) p0[r] = -INFINITY; if (kv + 32 > qrel || kv + 32 <= qrel - 128) p1[r] = -INFINITY; } } }

template <int MODE>
__device__ __forceinline__ void unit(int h, int qb, const bf16* Q, const bf16* __restrict__ K, const bf16* __restrict__ V, bf16* O, const float* KM, float slope2, float sink2, lds_ptr lds) {
    constexpr int DMK = MODE ? 256 : 1024;
    const int kvcol = MODE ? 64 * (h >> 2) : 64 * h;
    int tid = threadIdx.x; asm volatile("" : "+v"(tid));
    const int lane = tid & 63, r32 = lane & 31, hi = lane >> 5; const int wid = __builtin_amdgcn_readfirstlane(tid >> 6);
    const int q0 = qb * QB, NT = (q0 + QB) / KVBLK, NB = NT - 4;
    const int T0 = MODE ? (NB >= 2 ? NB - 2 : 0) : 0;
    const bf16* Qw = Q + (size_t)(q0 + wid * QBLK) * DMQ + h * D;
    const unsigned lds0 = (unsigned)(uintptr_t)lds; __attribute__((address_space(3))) float* wsf = (__attribute__((address_space(3))) float*)(lds + LDS_WS) + wid * 64;
    const bf16* ksrc = K + kvcol + (size_t)lane * DMK + wid * 8;
    const bf16* vsrc = V + kvcol + (size_t)(16 * (wid & 3) + (lane >> 2)) * DMK + (wid >> 2) * 32 + (lane & 3) * 8;
    const unsigned kdst = lds0 + LDS_K + wid * 1024, vdst = lds0 + LDS_V + wid * 1024;
#define DMA_K(t, slot) glds16(ksrc + (size_t)(t) * KVBLK * DMK, (unsigned)__builtin_amdgcn_readfirstlane(kdst + (slot)))
#define DMA_V(t, slot) glds16(vsrc + (size_t)(t) * KVBLK * DMK, (unsigned)__builtin_amdgcn_readfirstlane(vdst + (slot)))
    const lds_cptr vp0 = (lds_cptr)lds + LDS_V + ((lane >> 4) & 1) * 32 + (lane & 3) * 8 + (4 * hi + ((lane & 15) >> 2)) * 64;
    const lds_cptr kp0 = (lds_cptr)lds + LDS_K + hi * 1024 + r32 * 16;
    DMA_K(T0, 0); DMA_V(T0, 0); DMA_K(T0 + 1, SLOTB);
    bf16x8 qr[4];
#pragma unroll
    for (int d0 = 0; d0 < 4; ++d0) qr[d0] = *reinterpret_cast<const bf16x8*>(&Qw[(size_t)r32 * DMQ + d0 * 16 + hi * 8]);
#ifndef ATT_KM_GLOBAL
    if (MODE == 0 && qb > 0) {
        if (tid * 4 < qb * 64) { const f32x4 kmv = *(const __attribute__((address_space(1))) f32x4*)(KM + 4 * tid); *(__attribute__((address_space(3))) f32x4*)(lds + LDS_OST + 16 * tid) = kmv; } }
#endif
    float mhat = 0.f, l_reg = 0.f; f32x16 o[2]; o[0] = f32x16{}; o[1] = f32x16{};
    f32x16 ab0;
#pragma unroll
    for (int r = 0; r < 16; ++r) ab0[r] = slope2 * (float)crow(r, hi);
    PIN(ab0); const float c32 = 32.0f * slope2;
    const int qrel = wid * QBLK + r32; bool resc = false;
    f32x16 pA0, pA1, pB0, pB1; bf16x8 kf[8]; s16x4 vlo[8], vhi[8]; u32x4 pw0, pw1, pw2, pw3;
    int sl_prev = 0, sl_cur = 0, sl_next = SLOTB;
#define ROT() do { sl_prev = sl_cur; sl_cur = sl_next; sl_next = (sl_next == 2 * SLOTB) ? 0 : sl_next + SLOTB; } while (0)
#define EX(v, NM) __builtin_amdgcn_exp2f((v) + (NM))
#define RESC() do { if (resc) { _Pragma("unroll") for (int d_ = 0; d_ < 2; ++d_) _Pragma("unroll") for (int r = 0; r < 16; ++r) o[d_][r] *= wsf[crow(r, hi)]; } } while (0)
    DMA_K(T0 + 2, 2 * SLOTB);
    WAIT_BAR(3);
    unsigned selmask = 0u;
    if (MODE == 0 && qb > 0) {
        float qf[32];
#pragma unroll
        for (int d0 = 0; d0 < 4; ++d0)
#pragma unroll
            for (int i = 0; i < 8; ++i) qf[d0 * 8 + i] = __uint_as_float(((unsigned)(unsigned short)qr[d0][i]) << 16);
#ifdef ATT_KM_GLOBAL
        const float* kmL = KM + 8 * hi;
#define KMAS
#else
        const __attribute__((address_space(3))) float* kmL = (const __attribute__((address_space(3))) float*)(lds + LDS_OST) + 8 * hi;
#define KMAS __attribute__((address_space(3)))
#endif
        float b0 = -INFINITY, b1 = -INFINITY, b2 = -INFINITY; int i0 = -1, i1 = -1, i2 = -1;
        for (int j = 0; j < qb; ++j) {
            float p = 0.f;
#pragma unroll
            for (int d0 = 0; d0 < 4; ++d0) { const f32x4 ka = *(const KMAS f32x4*)(kmL + j * 64 + 16 * d0), kb = *(const KMAS f32x4*)(kmL + j * 64 + 16 * d0 + 4);
                p += qf[8 * d0 + 0] * ka.x + qf[8 * d0 + 1] * ka.y + qf[8 * d0 + 2] * ka.z + qf[8 * d0 + 3] * ka.w + qf[8 * d0 + 4] * kb.x + qf[8 * d0 + 5] * kb.y + qf[8 * d0 + 6] * kb.z + qf[8 * d0 + 7] * kb.w; }
            auto rr = __builtin_amdgcn_permlane32_swap(__float_as_uint(p), __float_as_uint(p), false, false);
            const float v = __uint_as_float(rr[0]) + __uint_as_float(rr[1]);
            if (v > b0) { b2 = b1; i2 = i1; b1 = b0; i1 = i0; b0 = v; i0 = j; }
            else if (v > b1) { b2 = b1; i2 = i1; b1 = v; i1 = j; }
            else if (v > b2) { b2 = v; i2 = j; }
        }
        if (i0 >= 0) selmask |= 1u << i0; if (i1 >= 0) selmask |= 1u << i1; if (i2 >= 0) selmask |= 1u << i2;
    }
#define TB(t) (slope2 * (float)(64 * ((t) - NB) - 255))
#define SELROW(t) (((selmask >> ((t) >> 2)) & 1u) != 0u)
    _Pragma("unroll") for (int d0 = 0; d0 < 4; ++d0) kload2(kf, kp0, d0);
    pA0 = MFMA(kf[0], qr[0], ab0); pA1 = MFMA(kf[1], qr[0], ab0); pA0 = MFMA(kf[2], qr[1], pA0); pA1 = MFMA(kf[3], qr[1], pA1);
    pA0 = MFMA(kf[4], qr[2], pA0); pA1 = MFMA(kf[5], qr[2], pA1); pA0 = MFMA(kf[6], qr[3], pA0); pA1 = MFMA(kf[7], qr[3], pA1);
    { float nmp = TB(T0);
      if (MODE == 0 && T0 < NB) { nmp = SELROW(T0) ? nmp : -INFINITY; } else tmask<MODE>(pA0, pA1, T0 - NB, qrel, hi);
      const float rm = rowmax(pA0, pA1, c32) + nmp; mhat = __builtin_fmaxf(rm, slope2 * (float)(qrel - 255)); const float nmh = nmp - mhat, nmh1 = nmh + c32;
#pragma unroll
      for (int r = 0; r < 16; ++r) { pA0[r] = EX(pA0[r], nmh); pA1[r] = EX(pA1[r], nmh1); } }
    WAIT_BAR(0);
    DMA_K(T0 + 3, 0); DMA_V(T0 + 1, SLOTB); ROT();
    _Pragma("unroll") for (int d0 = 0; d0 < 4; ++d0) kload2(kf, kp0 + sl_cur, d0);
    WAIT_BAR(2);
#define PKW(P, i) cvtpk(P[i], P[i + 1])
#define PAF(k) __builtin_bit_cast(bf16x8, pw##k)
#define VFR(i) (bf16x8){vlo[i][0], vlo[i][1], vlo[i][2], vlo[i][3], vhi[i][0], vhi[i][1], vhi[i][2], vhi[i][3]}
#define VRD(i) do { vlo[i] = vtr(vp_ + (((i) >> 2) * 4096 + ((i) & 3) * 1024)); vhi[i] = vtr(vp_ + (((i) >> 2) * 4096 + ((i) & 3) * 1024 + 512)); } while (0)
#define KRD(G, d0) do { if (G) { kload2(kf, kp0 + sl_next, d0); SBAR(); } } while (0)
#define GAPA(MF, a0, a1, a2, a3, W0, W1, PW) do { MF; sacc += a0; sacc += a1; sacc += a2; sacc += a3; W0; W1; PIN(PW); PIN(sacc); SBAR(); } while (0)
#define GAPB(MF, X, i, NM) do { MF; X[i] = EX(X[i], NM); X[i + 1] = EX(X[i + 1], NM); X[i + 2] = EX(X[i + 2], NM); X[i + 3] = EX(X[i + 3], NM); PIN(X); SBAR(); } while (0)
#define STEP(C0, C1, P0, P1, t, KIND, GK, GV, GL) do { SBAR(); \
    const lds_cptr vp_ = vp0 + sl_prev; \
    VRD(0); SBAR(); float sacc = P0[0] + P0[1]; \
                    GAPA(C0 = MFMA(kf[0], qr[0], ab0),   P0[2], P0[3], P0[4], P0[5],     pw0[0] = PKW(P0, 0),  pw0[1] = PKW(P0, 2),  pw0); \
    VRD(4); SBAR(); GAPA(C1 = MFMA(kf[1], qr[0], ab0),   P0[6], P0[7], P0[8], P0[9],     pw0[2] = PKW(P0, 4),  pw0[3] = PKW(P0, 6),  pw0); \
    VRD(1); SBAR(); GAPA(C0 = MFMA(kf[2], qr[1], C0),    P0[10], P0[11], P0[12], P0[13], pw1[0] = PKW(P0, 8),  pw1[1] = PKW(P0, 10), pw1); \
    VRD(5); SBAR(); GAPA(C1 = MFMA(kf[3], qr[1], C1),    P0[14], P0[15], P1[0], P1[1],   pw1[2] = PKW(P0, 12), pw1[3] = PKW(P0, 14), pw1); \
    VRD(2); SBAR(); GAPA(C0 = MFMA(kf[4], qr[2], C0),    P1[2], P1[3], P1[4], P1[5],     pw2[0] = PKW(P1, 0),  pw2[1] = PKW(P1, 2),  pw2); \
    VRD(6); SBAR(); GAPA(C1 = MFMA(kf[5], qr[2], C1),    P1[6], P1[7], P1[8], P1[9],     pw2[2] = PKW(P1, 4),  pw2[3] = PKW(P1, 6),  pw2); \
    VRD(3); SBAR(); GAPA(C0 = MFMA(kf[6], qr[3], C0),    P1[10], P1[11], P1[12], P1[13], pw3[0] = PKW(P1, 8),  pw3[1] = PKW(P1, 10), pw3); \
    VRD(7); SBAR(); GAPA(C1 = MFMA(kf[7], qr[3], C1),    P1[14], P1[15], 0.f, 0.f,       pw3[2] = PKW(P1, 12), pw3[3] = PKW(P1, 14), pw3); \
    l_reg += sacc; \
    if (GK) DMA_K((t) + 3, sl_cur); if (GV) DMA_V((t) + 1, sl_next); \
    float nmh = TB(t) - mhat; \
    if (KIND == 0) { if (MODE == 0) nmh = SELROW(t) ? nmh : -INFINITY; } \
    else { if (MODE == 0 && (t) < NB) nmh = SELROW(t) ? nmh : -INFINITY; else tmask<MODE>(C0, C1, (t) - NB, qrel, hi); } \
    { const float rm = rowmax(C0, C1, c32) + nmh; resc = false; \
      if (__builtin_expect(__any(rm > THR), 0)) { const float dl = __builtin_fmaxf(rm, 0.f); mhat += dl; nmh -= dl; \
          const float f = __builtin_amdgcn_exp2f(-dl); l_reg *= f; if (hi == 0) wsf[r32] = f; resc = true; } } \
    const float nmh1 = nmh + c32; SBAR(); \
    GAPB(o[0] = MFMA(PAF(0), VFR(0), o[0]), C0, 0, nmh);              GAPB(o[1] = MFMA(PAF(0), VFR(4), o[1]), C0, 4, nmh); \
    KRD(GL, 0); GAPB(o[0] = MFMA(PAF(1), VFR(1), o[0]), C0, 8, nmh);  KRD(GL, 1); GAPB(o[1] = MFMA(PAF(1), VFR(5), o[1]), C0, 12, nmh); \
    KRD(GL, 2); GAPB(o[0] = MFMA(PAF(2), VFR(2), o[0]), C1, 0, nmh1);  KRD(GL, 3); GAPB(o[1] = MFMA(PAF(2), VFR(6), o[1]), C1, 4, nmh1); \
    GAPB(o[0] = MFMA(PAF(3), VFR(3), o[0]), C1, 8, nmh1);              GAPB(o[1] = MFMA(PAF(3), VFR(7), o[1]), C1, 12, nmh1); \
    } while (0)
    int t = T0 + 1;
    for (; t + 5 < NT; t += 2) {
        STEP(pB0, pB1, pA0, pA1, t, 0, true, true, true);     WAIT_BAR(2); RESC(); ROT();
        STEP(pA0, pA1, pB0, pB1, t + 1, 0, true, true, true); WAIT_BAR(2); RESC(); ROT();
    }
#define ENDW(tt) do { if ((tt) + 3 < NT) { WAIT_BAR(2); } else if ((tt) + 2 < NT) { WAIT_BAR(1); } else { WAIT_BAR(0); } } while (0)
    for (; t + 1 < NT; t += 2) {
        STEP(pB0, pB1, pA0, pA1, t, 1, (t + 3 < NT), (t + 1 < NT), (t + 1 < NT));         ENDW(t);     RESC(); ROT();
        STEP(pA0, pA1, pB0, pB1, t + 1, 1, (t + 4 < NT), (t + 2 < NT), (t + 2 < NT));     ENDW(t + 1); RESC(); ROT();
    }
    STEP(pB0, pB1, pA0, pA1, NT - 1, 1, false, false, false); RESC();
    { float sacc = pB0[0] + pB0[1];
#pragma unroll
      for (int r = 2; r < 16; ++r) sacc += pB0[r];
#pragma unroll
      for (int r = 0; r < 16; ++r) sacc += pB1[r];
      l_reg += sacc;
      pw0 = (u32x4){PKW(pB0, 0), PKW(pB0, 2), PKW(pB0, 4), PKW(pB0, 6)}; pw1 = (u32x4){PKW(pB0, 8), PKW(pB0, 10), PKW(pB0, 12), PKW(pB0, 14)};
      pw2 = (u32x4){PKW(pB1, 0), PKW(pB1, 2), PKW(pB1, 4), PKW(pB1, 6)}; pw3 = (u32x4){PKW(pB1, 8), PKW(pB1, 10), PKW(pB1, 12), PKW(pB1, 14)};
      const lds_cptr vp_ = vp0 + sl_cur; _Pragma("unroll") for (int i = 0; i < 8; ++i) VRD(i);
      o[0] = MFMA(PAF(0), VFR(0), o[0]); o[1] = MFMA(PAF(0), VFR(4), o[1]); o[0] = MFMA(PAF(1), VFR(1), o[0]); o[1] = MFMA(PAF(1), VFR(5), o[1]);
      o[0] = MFMA(PAF(2), VFR(2), o[0]); o[1] = MFMA(PAF(2), VFR(6), o[1]); o[0] = MFMA(PAF(3), VFR(3), o[0]); o[1] = MFMA(PAF(3), VFR(7), o[1]); }
    { auto rr = __builtin_amdgcn_permlane32_swap(__float_as_uint(l_reg), __float_as_uint(l_reg), false, false); l_reg = __uint_as_float(rr[0]) + __uint_as_float(rr[1]); }
    if (MODE == 1) l_reg += __builtin_amdgcn_exp2f(sink2 + slope2 * (float)(qrel - 255) - mhat);
    if (hi == 0) wsf[32 + r32] = l_reg; asm volatile("s_waitcnt lgkmcnt(0)" ::: "memory");
    float rli[16];
#pragma unroll
    for (int r = 0; r < 16; ++r) rli[r] = __builtin_amdgcn_rcpf(wsf[32 + crow(r, hi)]);
    bf16* Ow = O + (size_t)(q0 + wid * QBLK) * DMQ + h * D; __attribute__((address_space(3))) bf16* stg = (__attribute__((address_space(3))) bf16*)(lds + LDS_OST) + wid * 2048;
#pragma unroll
    for (int r = 0; r < 16; ++r) { const int orow = crow(r, hi);
#pragma unroll
        for (int d0 = 0; d0 < 2; ++d0) stg[orow * 64 + d0 * 32 + r32] = (bf16)f2bf(o[d0][r] * rli[r]); }
    asm volatile("s_waitcnt lgkmcnt(0)" ::: "memory");
#pragma unroll
    for (int i = 0; i < 4; ++i) { const int row = i * 8 + (lane >> 3), ch = lane & 7; *(u32x4*)(Ow + (size_t)row * DMQ + ch * 8) = *(const __attribute__((address_space(3))) u32x4*)(stg + row * 64 + ch * 8); }
    asm volatile("s_waitcnt lgkmcnt(0)\n\ts_barrier" ::: "memory");
#undef DMA_K
#undef DMA_V
#undef ROT
#undef EX
#undef RESC
#undef PKW
#undef PAF
#undef VFR
#undef VRD
#undef KRD
#undef ENDW
#undef GAPA
#undef GAPB
#undef STEP
#undef TB
#undef SELROW
}
#undef SBAR
#undef PIN
#undef MFMA
#undef WAIT_BAR
#undef MX3
}

constexpr int S = 8192, DM = 2048, HD = 64, NH = 16;
constexpr int NIN = 8704, NEXP = 32, DEXP = 512, NMOD = 12288;
constexpr float RMS_EPS = 1e-6f;
constexpr float LOG2E = 1.4426950408889634f;
constexpr float C2 = 0.125f * LOG2E;
constexpr int NWAVES = 8, NTHREADS = 512;
constexpr int PER_PHASE = 12;
constexpr int N_LAUNCHES = MK_N_LAUNCHES;

constexpr size_t MiB = 1u << 20;
constexpr size_t WS_CTL = 0, CTL_ZERO_BYTES = 1 * MiB;
constexpr size_t WS_MODP = 1 * MiB;
constexpr size_t WS_MOD = WS_MODP + 1536 * 1024;
constexpr size_t WS_KMEAN = WS_MOD + 64 * 1024;
constexpr size_t WS_WRT = WS_KMEAN + 128 * 1024;
constexpr size_t WS_SSQ = WS_WRT + 288 * 1024;
constexpr size_t WS_EW = WS_SSQ + MiB;
constexpr size_t WS_LIST = WS_EW + 64 * 1024;
constexpr size_t WS_DESC = WS_LIST + MiB;
constexpr size_t WS_SMALL_END = WS_DESC + 192 * 1024;
static_assert(WS_SMALL_END <= 6 * MiB, "small region");
constexpr size_t WS_WT_OAB = 6 * MiB;
constexpr size_t WS_WT_OUT = 14 * MiB;
constexpr size_t WS_WT_IN = 22 * MiB;
constexpr size_t WS_WT_GU = 56 * MiB;
constexpr size_t WS_WT_D = 184 * MiB;
constexpr size_t WS_XN = 248 * MiB;
constexpr size_t WS_QA = 280 * MiB, WS_KA = 296 * MiB, WS_VA = 312 * MiB, WS_QB = 328 * MiB, WS_KB = 344 * MiB, WS_VB = 348 * MiB;
constexpr size_t WS_SGA = 352 * MiB, WS_SGB = 384 * MiB;
constexpr size_t WS_Y1 = 416 * MiB;
constexpr size_t WS_Y = 448 * MiB;
constexpr size_t WS_TMPA = 512 * MiB;
constexpr size_t WS_OAB = 576 * MiB;
constexpr size_t WS_END = 608 * MiB;
constexpr size_t WS_YE = 280 * MiB;
constexpr size_t WS_ACT = 416 * MiB;
constexpr size_t WS_XG = 448 * MiB;
constexpr int MAXROWS = 24576;
static_assert(WS_XG + (size_t)MAXROWS * DM * 2 <= WS_OAB && WS_YE + (size_t)S * 2 * DM * 4 <= WS_Y1, "overlays");
constexpr int CW_TMO = 0, CW_CODE = 1, CW_BAR = 4096, CW_CNT = 8192;

constexpr int RING_OFF = 0, RING_BYTES = 131072;
constexpr int LDSCTL_OFF = RING_BYTES;
constexpr int LDS_BYTES = 147456;

typedef unsigned u32x4_t __attribute__((ext_vector_type(4)));
typedef float f32x2_t __attribute__((ext_vector_type(2)));

__device__ __forceinline__ float bf2f(unsigned short b) { return __uint_as_float(((unsigned)b) << 16); }
__device__ __forceinline__ float bflo(unsigned w) { return __uint_as_float(w << 16); }
__device__ __forceinline__ float bfhi(unsigned w) { return __uint_as_float(w & 0xffff0000u); }
__device__ __forceinline__ float wave_sum(float v) {
#pragma unroll
    for (int o = 1; o < 64; o <<= 1) v += __shfl_xor(v, o);
    return v;
}
__device__ __forceinline__ float wave_max(float v) {
#pragma unroll
    for (int o = 1; o < 64; o <<= 1) v = fmaxf(v, __shfl_xor(v, o));
    return v;
}
__device__ __forceinline__ float sigmoidf_(float v) { return __builtin_amdgcn_rcpf(1.0f + __builtin_amdgcn_exp2f(-v * LOG2E)); }

struct Ctx {
    const float* in[20]; float* out; unsigned char* ws;
    int tid, lane, wave, G, vcu;
    LAS unsigned char* lds;
};
enum { I_X = 0, I_C, I_WADA, I_BADA, I_GPRE, I_GPOST, I_WIN, I_SINKS, I_WOA, I_WOB, I_WOUT, I_GPREF, I_GPOSTF, I_WRG, I_BRG, I_WRE, I_BRE, I_WG, I_WU, I_WD };

__device__ __forceinline__ void tr_item(const float* W, int N, bf16* WT, int ldt, int wt_row0, int k0, int n0, LAS float* scr, int lane) {
#pragma unroll 8
    for (int i = 0; i < 32; ++i) { const int kk = 2 * i + (lane >> 5); scr[kk * 33 + (lane & 31)] = W[(size_t)(k0 + kk) * N + n0 + (lane & 31)]; }
    LDS_WAIT(); asm volatile("" ::: "memory");
    const int c = lane & 7;
#pragma unroll
    for (int j = 0; j < 4; ++j) { const int n = (lane >> 3) + 8 * j; const LAS float* s = scr + (8 * c) * 33 + n;
        v4u o; o.x = pk2(s[0 * 33], s[1 * 33]); o.y = pk2(s[2 * 33], s[3 * 33]); o.z = pk2(s[4 * 33], s[5 * 33]); o.w = pk2(s[6 * 33], s[7 * 33]);
        *(GAS v4u*)(WT + (size_t)(wt_row0 + n) * ldt + k0 + 8 * c) = o; }
    LDS_WAIT(); asm volatile("" ::: "memory");
}
__device__ __forceinline__ void phase0(Ctx& F) {
    LAS float* scr = (LAS float*)(F.lds + RING_OFF + F.wave * 16384);
    const int gw = F.vcu * NWAVES + F.wave, NGW = F.G * NWAVES, lane = F.lane;
    constexpr int I_GEMV = 32 * 48, I_RT = 36;
    constexpr int I_IN = 32 * 272, I_OA = 16 * 64, I_OUT = 32 * 64, I_E = 32 * 512;
    constexpr int NITEMS = I_GEMV + I_RT + I_IN + 2 * I_OA + I_OUT + 3 * I_E;
    bf16* WT_OAB = (bf16*)(F.ws + WS_WT_OAB); bf16* WT_OUT = (bf16*)(F.ws + WS_WT_OUT); bf16* WT_IN = (bf16*)(F.ws + WS_WT_IN);
    bf16* WT_GU = (bf16*)(F.ws + WS_WT_GU); bf16* WT_D = (bf16*)(F.ws + WS_WT_D);
    for (int it = gw; it < NITEMS; it += NGW) {
        int r = it;
        if (r < I_GEMV) {
            const int kc = r / 48, span = r % 48;
            const float cv = F.in[I_C][64 * kc + lane];
            const float sv = cv / (1.0f + expf(-cv));
            f32x4 acc = {0.f, 0.f, 0.f, 0.f};
            const float* wp = F.in[I_WADA] + (size_t)(64 * kc) * NMOD + 256 * span + 4 * lane;
#pragma unroll 8
            for (int rr = 0; rr < 64; ++rr) { const f32x4 w = *(const GAS f32x4*)(wp + (size_t)rr * NMOD); const float s = __shfl(sv, rr); acc += w * s; }
            *(GAS f32x4*)((float*)(F.ws + WS_MODP) + (size_t)kc * NMOD + 256 * span + 4 * lane) = acc;
            continue;
        }
        r -= I_GEMV;
        if (r < I_RT) {
            float* wrt = (float*)(F.ws + WS_WRT) + (size_t)r * DM;
            for (int d = lane; d < DM; d += 64) wrt[d] = (r < 4) ? F.in[I_WRG][d * 4 + r] : F.in[I_WRE][d * 32 + (r - 4)];
            continue;
        }
        r -= I_RT;
        if (r < I_IN) { const int kb = r / 272, nb = r % 272; tr_item(F.in[I_WIN], NIN, WT_IN, DM, 32 * nb, 64 * kb, 32 * nb, scr, lane); continue; }
        r -= I_IN;
        if (r < I_OA) { const int kb = r / 64, nb = r % 64; tr_item(F.in[I_WOA], DM, WT_OAB, 1024, 32 * nb, 64 * kb, 32 * nb, scr, lane); continue; }
        r -= I_OA;
        if (r < I_OA) { const int kb = r / 64, nb = r % 64; tr_item(F.in[I_WOB], DM, WT_OAB + (size_t)DM * 1024, 1024, 32 * nb, 64 * kb, 32 * nb, scr, lane); continue; }
        r -= I_OA;
        if (r < I_OUT) { const int kb = r / 64, nb = r % 64; tr_item(F.in[I_WOUT], DM, WT_OUT, DM, 32 * nb, 64 * kb, 32 * nb, scr, lane); continue; }
        r -= I_OUT;
        if (r < I_E) { const int e = r / 512, rr = r % 512, kb = rr / 16, nb = rr % 16, n0 = 32 * nb;
            tr_item(F.in[I_WG] + (size_t)e * DM * DEXP, DEXP, WT_GU, DM, e * 1024 + 256 * (n0 >> 7) + (n0 & 127), 64 * kb, n0, scr, lane); continue; }
        r -= I_E;
        if (r < I_E) { const int e = r / 512, rr = r % 512, kb = rr / 16, nb = rr % 16, n0 = 32 * nb;
            tr_item(F.in[I_WU] + (size_t)e * DM * DEXP, DEXP, WT_GU, DM, e * 1024 + 256 * (n0 >> 7) + 128 + (n0 & 127), 64 * kb, n0, scr, lane); continue; }
        r -= I_E;
        { const int e = r / 512, rr = r % 512, kb = rr / 64, nb = rr % 64;
            tr_item(F.in[I_WD] + (size_t)e * DEXP * DM, DM, WT_D, DEXP, e * 2048 + 32 * nb, 64 * kb, 32 * nb, scr, lane); }
    }
}

__device__ __forceinline__ float mod_value(const Ctx& F, int n) {
    const float* mp = (const float*)(F.ws + WS_MODP) + n;
    float s = F.in[I_BADA][n];
#pragma unroll 8
    for (int kc = 0; kc < 32; ++kc) s += mp[(size_t)kc * NMOD];
    return s;
}
__device__ __forceinline__ void phase1(Ctx& F) {
    LAS float* gs = (LAS float*)(F.lds + RING_OFF);
    LAS float* sh = gs + DM;
    for (int n = F.tid; n < DM; n += NTHREADS) { const float shv = mod_value(F, n), scv = mod_value(F, DM + n); gs[n] = F.in[I_GPRE][n] * (1.0f + scv); sh[n] = shv; }
    { const int per = NMOD / F.G + 1; const int n = blockIdx.x * per + F.tid; if (F.tid < per && n < NMOD) ((float*)(F.ws + WS_MOD))[n] = mod_value(F, n); }
    __syncthreads();
    const int gw = F.vcu * NWAVES + F.wave, NGW = F.G * NWAVES, lane = F.lane;
    bf16* XN = (bf16*)(F.ws + WS_XN);
    for (int m = gw; m < S; m += NGW) {
        const GAS f32x4* xr = (const GAS f32x4*)(F.in[I_X] + (size_t)m * DM) + lane;
        f32x4 v[8]; float s2 = 0.f;
#pragma unroll
        for (int j = 0; j < 8; ++j) { v[j] = xr[64 * j]; s2 += (v[j].x * v[j].x + v[j].y * v[j].y) + (v[j].z * v[j].z + v[j].w * v[j].w); }
        const float rstd = 1.0f / sqrtf(wave_sum(s2) * (1.0f / DM) + RMS_EPS);
        GAS unsigned long long* o8 = (GAS unsigned long long*)(XN + (size_t)m * DM) + lane;
#pragma unroll
        for (int j = 0; j < 8; ++j) { const int d = 4 * lane + 256 * j; const f32x4 g4 = *(const LAS f32x4*)(gs + d), s4 = *(const LAS f32x4*)(sh + d);
            const f32x4 h = v[j] * rstd * g4 + s4;
            o8[64 * j] = (unsigned long long)pk2(h.x, h.y) | ((unsigned long long)pk2(h.z, h.w) << 32); }
    }
    __syncthreads();
}

template <class Epi, class Sched>
__device__ __forceinline__ void gemm_naive(const pg8::Gemm g, const Sched& Sc, const Epi& E) {
    using namespace pg8;
    const int tid = threadIdx.x, wid = __builtin_amdgcn_readfirstlane(tid >> 6), lane = tid & 63, wr = wid >> 2, wc = wid & 3, fr = lane & 15, fq = lane >> 4;
    const int K = g.K;
    Unit u;
    for (int i = 0; Sc.next(i, u); ++i) {
        pg8::f32x4 acc[2][2][4][2];
#pragma unroll
        for (int a = 0; a < 2; ++a)
#pragma unroll
            for (int b = 0; b < 2; ++b)
#pragma unroll
                for (int m = 0; m < 4; ++m)
#pragma unroll
                    for (int n = 0; n < 2; ++n) acc[a][b][m][n] = (pg8::f32x4){0.f, 0.f, 0.f, 0.f};
        const bf16_t* Ab = g.A + (size_t)u.pm * 256 * K; const bf16_t* Bb = g.Bt + (size_t)u.pn * 256 * K;
        const bf16_t* Ap = Ab + (size_t)(64 * wr + fr) * K + 8 * fq;
        const bf16_t* Bp = Bb + (size_t)(32 * wc) * K + 8 * fq;
        const int c0 = Epi::PERM ? perm32(fr) : fr, c1 = Epi::PERM ? perm32(16 + fr) : 16 + fr;
#pragma unroll 1
        for (int k0 = 0; k0 < K; k0 += 32) {
            pg8::bf16x8 b[2][2];
#pragma unroll
            for (int bj = 0; bj < 2; ++bj) { b[bj][0] = *(const pg8::bf16x8*)(Bp + (size_t)(128 * bj + c0) * K + k0); b[bj][1] = *(const pg8::bf16x8*)(Bp + (size_t)(128 * bj + c1) * K + k0); }
#pragma unroll
            for (int ai = 0; ai < 2; ++ai) {
                pg8::bf16x8 a[4];
#pragma unroll
                for (int m = 0; m < 4; ++m) a[m] = *(const pg8::bf16x8*)(Ap + (size_t)(128 * ai + 16 * m) * K + k0);
#pragma unroll
                for (int bj = 0; bj < 2; ++bj)
#pragma unroll
                    for (int m = 0; m < 4; ++m)
#pragma unroll
                        for (int n = 0; n < 2; ++n) acc[ai][bj][m][n] = __builtin_amdgcn_mfma_f32_16x16x32_bf16(b[bj][n], a[m], acc[ai][bj][m][n], 0, 0, 0);
                asm volatile("" ::: "memory");
            }
        }
        E(acc, u, wr, wc, fr, fq);
    }
}
template <class Epi, class Sched>
__device__ __forceinline__ void run_gemm(Ctx& F, const pg8::Gemm g, const Sched& Sc, const Epi& E) {
#if FAST_GEMM
    pg8::gemm_phase<Epi, Sched, true, true>((PG8_LAS unsigned char*)(F.lds + RING_OFF), g, Sc, E);
#else
    gemm_naive<Epi, Sched>(g, Sc, E);
#endif
}

typedef pg8::f32x4 acc_t[2][2][4][2];
struct EpiQKVG {
    static constexpr bool PERM = true, AFTER_DRAIN = false;
    unsigned char* ws;
    __device__ __forceinline__ void operator()(const acc_t& acc, const pg8::Unit& u, int wr, int wc, int fr, int fq) const {
        const int pn = u.pn; bf16* base; int ldc, colt; float sc = 1.0f; bool sig = false;
        if (pn < 4) { base = (bf16*)(ws + WS_QA); ldc = 1024; colt = 256 * pn; sc = C2; }
        else if (pn < 8) { base = (bf16*)(ws + WS_KA); ldc = 1024; colt = 256 * (pn - 4); }
        else if (pn < 12) { base = (bf16*)(ws + WS_VA); ldc = 1024; colt = 256 * (pn - 8); }
        else if (pn < 16) { base = (bf16*)(ws + WS_QB); ldc = 1024; colt = 256 * (pn - 12); sc = C2; }
        else if (pn == 16) { base = (bf16*)(ws + WS_KB); ldc = 256; colt = 0; }
        else if (pn == 17) { base = (bf16*)(ws + WS_VB); ldc = 256; colt = 0; }
        else if (pn < 26) { base = (bf16*)(ws + WS_SGA); ldc = 2048; colt = 256 * (pn - 18); sig = true; }
        else { base = (bf16*)(ws + WS_SGB); ldc = 2048; colt = 256 * (pn - 26); sig = true; }
        const int row0 = u.pm * 256 + wr * 64 + fr, col0 = colt + wc * 32 + 8 * fq;
#pragma unroll
        for (int ai = 0; ai < 2; ++ai)
#pragma unroll
            for (int m = 0; m < 4; ++m) { bf16* rowp = base + (size_t)(row0 + ai * 128 + m * 16) * ldc + col0;
#pragma unroll
                for (int bj = 0; bj < 2; ++bj) { pg8::f32x4 v0 = acc[ai][bj][m][0], v1 = acc[ai][bj][m][1];
                    if (sig) { v0 = (pg8::f32x4){sigmoidf_(v0[0]), sigmoidf_(v0[1]), sigmoidf_(v0[2]), sigmoidf_(v0[3])}; v1 = (pg8::f32x4){sigmoidf_(v1[0]), sigmoidf_(v1[1]), sigmoidf_(v1[2]), sigmoidf_(v1[3])}; }
                    else { v0 = v0 * sc; v1 = v1 * sc; }
                    pg8::u32x4 w; w.x = pg8::cvt_pk_bf16(v0[0], v0[1]); w.y = pg8::cvt_pk_bf16(v0[2], v0[3]); w.z = pg8::cvt_pk_bf16(v1[0], v1[1]); w.w = pg8::cvt_pk_bf16(v1[2], v1[3]);
                    *(pg8::u32x4*)(rowp + bj * 128) = w; } }
    }
};
struct EpiGate {
    static constexpr bool PERM = true, AFTER_DRAIN = false;
    unsigned char* ws;
    __device__ __forceinline__ void operator()(const acc_t& acc, const pg8::Unit& u, int wr, int wc, int fr, int fq) const {
        const int which = u.pm >> 5, pm = u.pm & 31, pn = u.pn & 7;
        const bf16* SG = (const bf16*)(ws + (which ? WS_SGB : WS_SGA)); float* T = (float*)(ws + WS_TMPA); bf16* Y1 = (bf16*)(ws + WS_Y1);
        const int row0 = pm * 256 + wr * 64 + fr, col0 = pn * 256 + wc * 32 + 8 * fq;
#pragma unroll
        for (int ai = 0; ai < 2; ++ai)
#pragma unroll
            for (int m = 0; m < 4; ++m)
#pragma unroll
                for (int bj = 0; bj < 2; ++bj) { const size_t off = (size_t)(row0 + ai * 128 + m * 16) * DM + col0 + bj * 128;
                    const pg8::u32x4 sg = *(const pg8::u32x4*)(SG + off);
                    pg8::f32x4 v0 = acc[ai][bj][m][0], v1 = acc[ai][bj][m][1];
                    v0[0] *= bflo(sg.x); v0[1] *= bfhi(sg.x); v0[2] *= bflo(sg.y); v0[3] *= bfhi(sg.y);
                    v1[0] *= bflo(sg.z); v1[1] *= bfhi(sg.z); v1[2] *= bflo(sg.w); v1[3] *= bfhi(sg.w);
                    if (which == 0) { *(pg8::f32x4*)(T + off) = v0; *(pg8::f32x4*)(T + off + 4) = v1; }
                    else { const pg8::f32x4 t0 = *(const pg8::f32x4*)(T + off), t1 = *(const pg8::f32x4*)(T + off + 4); v0 += t0; v1 += t1;
                        pg8::u32x4 w; w.x = pg8::cvt_pk_bf16(v0[0], v0[1]); w.y = pg8::cvt_pk_bf16(v0[2], v0[3]); w.z = pg8::cvt_pk_bf16(v1[0], v1[1]); w.w = pg8::cvt_pk_bf16(v1[2], v1[3]);
                        *(pg8::u32x4*)(Y1 + off) = w; } }
    }
};
struct EpiY {
    static constexpr bool PERM = false, AFTER_DRAIN = false;
    unsigned char* ws;
    __device__ __forceinline__ void operator()(const acc_t& acc, const pg8::Unit& u, int wr, int wc, int fr, int fq) const {
        float* Y = (float*)(ws + WS_Y); float* SSQ = (float*)(ws + WS_SSQ);
        const int row0 = u.pm * 256 + wr * 64 + fr, col0 = u.pn * 256 + wc * 32 + 4 * fq;
#pragma unroll
        for (int ai = 0; ai < 2; ++ai)
#pragma unroll
            for (int m = 0; m < 4; ++m) { const int row = row0 + ai * 128 + m * 16; float ss = 0.f;
#pragma unroll
                for (int bj = 0; bj < 2; ++bj)
#pragma unroll
                    for (int n = 0; n < 2; ++n) { const pg8::f32x4 v = acc[ai][bj][m][n]; *(pg8::f32x4*)(Y + (size_t)row * DM + col0 + bj * 128 + n * 16) = v;
                        ss += (v[0] * v[0] + v[1] * v[1]) + (v[2] * v[2] + v[3] * v[3]); }
                ss += __shfl_xor(ss, 16); ss += __shfl_xor(ss, 32);
                if (fq == 0) SSQ[(size_t)row * 32 + u.pn * 4 + wc] = ss; }
    }
};
struct EpiGU {
    static constexpr bool PERM = true, AFTER_DRAIN = false;
    unsigned char* ws;
    __device__ __forceinline__ void operator()(const acc_t& acc, const pg8::Unit& u, int wr, int wc, int fr, int fq) const {
        bf16* ACT = (bf16*)(ws + WS_ACT);
        const int row0 = u.pm * 256 + wr * 64 + fr, col0 = (u.pn & 3) * 128 + wc * 32 + 8 * fq;
#pragma unroll
        for (int ai = 0; ai < 2; ++ai)
#pragma unroll
            for (int m = 0; m < 4; ++m) { float a[8];
#pragma unroll
                for (int n = 0; n < 2; ++n)
#pragma unroll
                    for (int i = 0; i < 4; ++i) { const float gv = acc[ai][0][m][n][i], uv = acc[ai][1][m][n][i]; a[4 * n + i] = gv * sigmoidf_(gv) * uv; }
                pg8::u32x4 w; w.x = pg8::cvt_pk_bf16(a[0], a[1]); w.y = pg8::cvt_pk_bf16(a[2], a[3]); w.z = pg8::cvt_pk_bf16(a[4], a[5]); w.w = pg8::cvt_pk_bf16(a[6], a[7]);
                *(pg8::u32x4*)(ACT + (size_t)(row0 + ai * 128 + m * 16) * DEXP + col0) = w; }
    }
};
struct EpiDown {
    static constexpr bool PERM = false, AFTER_DRAIN = false;
    unsigned char* ws;
    __device__ __forceinline__ void operator()(const acc_t& acc, const pg8::Unit& u, int wr, int wc, int fr, int fq) const {
        float* YE = (float*)(ws + WS_YE); const int2* DESC = (const int2*)(ws + WS_DESC);
        const int row0 = u.pm * 256 + wr * 64 + fr, col0 = (u.pn & 7) * 256 + wc * 32 + 4 * fq;
#pragma unroll
        for (int ai = 0; ai < 2; ++ai)
#pragma unroll
            for (int m = 0; m < 4; ++m) { const int2 d = DESC[row0 + ai * 128 + m * 16]; const float w = __int_as_float(d.y);
                if (d.x >= 0) {
#pragma unroll
                    for (int bj = 0; bj < 2; ++bj)
#pragma unroll
                        for (int n = 0; n < 2; ++n) *(pg8::f32x4*)(YE + (size_t)d.x * DM + col0 + bj * 128 + n * 16) = acc[ai][bj][m][n] * w; } }
    }
};

struct GateOrder {
    pg8::StaticOrder so;
    __device__ void init(int G, int c) { so.init(S, DM, G, c); }
    __device__ bool next(int i, pg8::Unit& u) const {
        const int rounds = (so.nwg + so.G - 1) / so.G;
        const int which = i & 1, ti = i >> 1; if (ti >= rounds) return false;
        pg8::Unit t; if (!so.next(ti, t)) return false;
        u.pm = t.pm + 32 * which; u.pn = t.pn + 8 * which; return true;
    }
    __device__ __forceinline__ void a_ready(const pg8::Unit&) const {}
    __device__ __forceinline__ void done(const pg8::Unit&) const {}
};
struct MoeOrder {
    const volatile LAS int* mts; int shift, G, v;
    __device__ bool next(int i, pg8::Unit& u) const {
        const int total = mts[32] << shift; const int L = i * G + v; if (L >= total) return false;
        const int mt = L >> shift, pn = L & ((1 << shift) - 1); int e = 0;
        for (int j = 1; j < 32; ++j) e += (mts[j] <= mt) ? 1 : 0;
        u.pm = mt; u.pn = (e << shift) | pn; return true;
    }
    __device__ __forceinline__ void a_ready(const pg8::Unit&) const {}
    __device__ __forceinline__ void done(const pg8::Unit&) const {}
};
__device__ __forceinline__ void build_mts(Ctx& F) {
    volatile LAS int* mts = (volatile LAS int*)(F.lds + LDSCTL_OFF) + 64;
    __syncthreads();
    if (F.tid == 0) { const gu32* cnt = (const gu32*)(F.ws + WS_CTL) + CW_CNT; int acc = 0;
        for (int e = 0; e < 32; ++e) { mts[e] = acc; const int c = (int)__hip_atomic_load(cnt + e, RLX_AGENT); acc += (c + 255) >> 8; }
        mts[32] = acc; }
    __syncthreads();
}

__device__ __forceinline__ void phase3(Ctx& F) {
    const int gw = F.vcu * NWAVES + F.wave, NGW = F.G * NWAVES, lane = F.lane;
    const bf16* KA = (const bf16*)(F.ws + WS_KA); float* KM = (float*)(F.ws + WS_KMEAN);
    for (int it = gw; it < 16 * 32; it += NGW) { const int h = it >> 5, j = it & 31; float s = 0.f;
        const bf16* p = KA + (size_t)(256 * j) * 1024 + 64 * h + lane;
#pragma unroll 8
        for (int r = 0; r < 256; ++r) s += bf2f(p[(size_t)r * 1024]);
        KM[(size_t)it * 64 + lane] = s * (1.0f / 256.0f); }
}

__device__ __forceinline__ void attn_naive(Ctx& F, int it_lo, int it_hi) {
    const int gw = F.vcu * NWAVES + F.wave, NGW = F.G * NWAVES, lane = F.lane;
    LAS float* wscr = (LAS float*)(F.lds + RING_OFF) + F.wave * 1280;
    LAS float* qs = wscr + 1024; LAS float* gsb = wscr + 1088;
    const bf16* QA = (const bf16*)(F.ws + WS_QA); const bf16* KA = (const bf16*)(F.ws + WS_KA); const bf16* VA = (const bf16*)(F.ws + WS_VA);
    const bf16* QB = (const bf16*)(F.ws + WS_QB); const bf16* KB = (const bf16*)(F.ws + WS_KB); const bf16* VB = (const bf16*)(F.ws + WS_VB);
    const float* KM = (const float*)(F.ws + WS_KMEAN);
    bf16* OA = (bf16*)(F.ws + WS_OAB); bf16* OB = OA + (size_t)S * 1024;
    const float NEG = -INFINITY;
    for (int it = it_lo + gw; it < it_hi; it += NGW) {
        const int mode = it / (S * NH), rem = it % (S * NH), t = rem >> 4, h = rem & 15;
        const float slope2 = exp2f(-0.5f * (float)(h + 1)) * LOG2E;
        if (mode == 0) {
            const int blk = t >> 8;
            qs[lane] = bf2f(QA[(size_t)t * 1024 + 64 * h + lane]);
            LDS_WAIT(); asm volatile("" ::: "memory");
            float g = NEG;
            if (lane < blk) { g = 0.f; const float* kmp = KM + (size_t)(h * 32 + lane) * 64; for (int d = 0; d < 64; ++d) g += qs[d] * kmp[d]; }
            if (lane < 32) gsb[lane] = g;
            LDS_WAIT(); asm volatile("" ::: "memory");
            float b0 = NEG, b1 = NEG, b2 = NEG; int i0 = -1, i1 = -1, i2 = -1;
            for (int j = 0; j < blk; ++j) { const float v = gsb[j];
                if (v > b0) { b2 = b1; i2 = i1; b1 = b0; i1 = i0; b0 = v; i0 = j; }
                else if (v > b1) { b2 = b1; i2 = i1; b1 = v; i1 = j; }
                else if (v > b2) { b2 = v; i2 = j; } }
            float mx = NEG; int nk = 0;
            for (int seg = 0; seg < 4; ++seg) { const int bj = seg == 0 ? i0 : seg == 1 ? i1 : seg == 2 ? i2 : blk; if (bj < 0) continue;
                const int nkeys = (seg == 3) ? (t & 255) + 1 : 256;
                for (int k0 = 0; k0 < nkeys; k0 += 64) { const int key = k0 + lane;
                    if (key < nkeys) { const int kp = bj * 256 + key; const GAS v4u* kr = (const GAS v4u*)(KA + (size_t)kp * 1024 + 64 * h); float s = 0.f;
#pragma unroll
                        for (int d8 = 0; d8 < 8; ++d8) { const v4u kv = kr[d8]; const LAS float* q8 = qs + 8 * d8;
                            s += q8[0] * bflo(kv.x) + q8[1] * bfhi(kv.x) + q8[2] * bflo(kv.y) + q8[3] * bfhi(kv.y) + q8[4] * bflo(kv.z) + q8[5] * bfhi(kv.z) + q8[6] * bflo(kv.w) + q8[7] * bfhi(kv.w); }
                        s += slope2 * (float)(kp - t); wscr[nk + key] = s; mx = fmaxf(mx, s); } }
                nk += nkeys; }
            mx = wave_max(mx);
            LDS_WAIT(); asm volatile("" ::: "memory");
            float l = 0.f, o = 0.f; int idx = 0;
            for (int seg = 0; seg < 4; ++seg) { const int bj = seg == 0 ? i0 : seg == 1 ? i1 : seg == 2 ? i2 : blk; if (bj < 0) continue;
                const int nkeys = (seg == 3) ? (t & 255) + 1 : 256;
                const bf16* vr = VA + (size_t)(bj * 256) * 1024 + 64 * h + lane;
                for (int key = 0; key < nkeys; ++key) { const float p = exp2f(wscr[idx + key] - mx); l += p; o += p * bf2f(vr[(size_t)key * 1024]); }
                idx += nkeys; }
            OA[(size_t)t * 1024 + 64 * h + lane] = (bf16)f2bf(o / l);
            LDS_WAIT(); asm volatile("" ::: "memory");
        } else {
            const int hkv = h >> 2; const float sink2 = F.in[I_SINKS][h] * LOG2E;
            qs[lane] = bf2f(QB[(size_t)t * 1024 + 64 * h + lane]);
            LDS_WAIT(); asm volatile("" ::: "memory");
            const int kp0 = t - 127 > 0 ? t - 127 : 0, nkeys = t - kp0 + 1;
            float mx = NEG;
            for (int k0 = 0; k0 < nkeys; k0 += 64) { const int key = k0 + lane;
                if (key < nkeys) { const int kp = kp0 + key; const GAS v4u* kr = (const GAS v4u*)(KB + (size_t)kp * 256 + 64 * hkv); float s = 0.f;
#pragma unroll
                    for (int d8 = 0; d8 < 8; ++d8) { const v4u kv = kr[d8]; const LAS float* q8 = qs + 8 * d8;
                        s += q8[0] * bflo(kv.x) + q8[1] * bfhi(kv.x) + q8[2] * bflo(kv.y) + q8[3] * bfhi(kv.y) + q8[4] * bflo(kv.z) + q8[5] * bfhi(kv.z) + q8[6] * bflo(kv.w) + q8[7] * bfhi(kv.w); }
                    s += slope2 * (float)(kp - t); wscr[key] = s; mx = fmaxf(mx, s); } }
            mx = wave_max(mx);
            LDS_WAIT(); asm volatile("" ::: "memory");
            float l = exp2f(sink2 - mx), o = 0.f;
            const bf16* vr = VB + (size_t)kp0 * 256 + 64 * hkv + lane;
            for (int key = 0; key < nkeys; ++key) { const float p = exp2f(wscr[key] - mx); l += p; o += p * bf2f(vr[(size_t)key * 256]); }
            OB[(size_t)t * 1024 + 64 * h + lane] = (bf16)f2bf(o / l);
            LDS_WAIT(); asm volatile("" ::: "memory");
        }
    }
}

__device__ __forceinline__ void attn_fast(Ctx& F, bool do_moba, bool do_swa, size_t out_ws = WS_OAB) {
    att::lds_ptr L = (att::lds_ptr)(F.lds + RING_OFF);
    const bf16* QA = (const bf16*)(F.ws + WS_QA); const bf16* KA = (const bf16*)(F.ws + WS_KA); const bf16* VA = (const bf16*)(F.ws + WS_VA);
    const bf16* QB = (const bf16*)(F.ws + WS_QB); const bf16* KB = (const bf16*)(F.ws + WS_KB); const bf16* VB = (const bf16*)(F.ws + WS_VB);
    const float* KM = (const float*)(F.ws + WS_KMEAN);
    bf16* OA = (bf16*)(F.ws + out_ws); bf16* OB = OA + (size_t)S * 1024;
    if (do_moba) for (int p = F.vcu; p < 256; p += F.G) {
        const int h = p >> 4, s = p & 15; const float slope2 = exp2f(-0.5f * (float)(h + 1)) * LOG2E;
        for (int k = 0; k < 2; ++k) att::unit<0>(h, k ? s : 31 - s, QA, KA, VA, OA, KM + (size_t)h * 32 * 64, slope2, 0.f, L);
    }
    if (do_swa) for (int p = F.vcu; p < 256; p += F.G) {
        for (int k = 0; k < 2; ++k) { const int u = 2 * p + k, h = u >> 5, qb = u & 31; const float slope2 = exp2f(-0.5f * (float)(h + 1)) * LOG2E;
            att::unit<1>(h, qb, QB, KB, VB, OB, nullptr, slope2, F.in[I_SINKS][h] * LOG2E, L); }
    }
}


#if defined(ATT_DIAG)
constexpr int CW_DIAG = 8320;
__device__ __forceinline__ void attn_diag_compare(Ctx& F) {
    const unsigned short* N0 = (const unsigned short*)(F.ws + WS_OAB); const unsigned short* F1 = (const unsigned short*)(F.ws + WS_Y); const unsigned short* F2 = (const unsigned short*)(F.ws + WS_TMPA);
    gu32* dg = (gu32*)(F.ws + WS_CTL) + CW_DIAG;
    const size_t n = (size_t)2 * S * 1024; unsigned ca = 0, cb = 0; float mx = 0.f;
    const size_t lo = (size_t)ATT_DIAG_LO * S * 1024, hi_ = (size_t)ATT_DIAG_HI * S * 1024;
    for (size_t i = lo + (size_t)blockIdx.x * NTHREADS + F.tid; i < hi_; i += (size_t)F.G * NTHREADS) {
        const unsigned short a = F1[i], b = F2[i]; if (a != b) ++ca;
        const float d = fabsf(bf2f(a) - bf2f(N0[i])); if (d > 0.02f + 0.02f * fabsf(bf2f(N0[i]))) { ++cb; __hip_atomic_fetch_add(dg + 16 + (int)((i >> 10) & 255), 1u, RLX_AGENT); __hip_atomic_fetch_add(dg + 16 + 256 + (int)((i >> 6) & 15), 1u, RLX_AGENT); } mx = fmaxf(mx, d); }
    (void)n;
    if (ca) __hip_atomic_fetch_add(dg + 0, ca, RLX_AGENT); if (cb) __hip_atomic_fetch_add(dg + 1, cb, RLX_AGENT);
    __hip_atomic_fetch_max(dg + 2, __float_as_uint(mx), RLX_AGENT);
}
#endif
__device__ __forceinline__ void phase7(Ctx& F) {
    LAS float* gm = (LAS float*)(F.lds + RING_OFF);
    LAS float* gsf = gm + DM;
    LAS float* shf = gsf + DM;
    const float* MOD = (const float*)(F.ws + WS_MOD);
    for (int n = F.tid; n < DM; n += NTHREADS) { gm[n] = MOD[2 * DM + n] * F.in[I_GPOST][n]; gsf[n] = F.in[I_GPREF][n] * (1.0f + MOD[4 * DM + n]); shf[n] = MOD[3 * DM + n]; }
    __syncthreads();
    const int gw = F.vcu * NWAVES + F.wave, NGW = F.G * NWAVES, lane = F.lane;
    const float* Y = (const float*)(F.ws + WS_Y); const float* SSQ = (const float*)(F.ws + WS_SSQ); const float* WRT = (const float*)(F.ws + WS_WRT);
    bf16* XN = (bf16*)(F.ws + WS_XN); float* EW = (float*)(F.ws + WS_EW); int* LIST = (int*)(F.ws + WS_LIST);
    gu32* CNT = (gu32*)(F.ws + WS_CTL) + CW_CNT;
    constexpr int R = 2;
    for (int m0 = gw * R; m0 < S; m0 += NGW * R) {
        f32x4 h[R][8];
#pragma unroll
        for (int r = 0; r < R; ++r) { const int m = m0 + r;
            const float ssq = wave_sum(lane < 32 ? SSQ[(size_t)m * 32 + lane] : 0.f);
            const float rstdy = 1.0f / sqrtf(ssq * (1.0f / DM) + RMS_EPS);
            const GAS f32x4* yr = (const GAS f32x4*)(Y + (size_t)m * DM) + lane; const GAS f32x4* xr = (const GAS f32x4*)(F.in[I_X] + (size_t)m * DM) + lane;
            GAS f32x4* xo = (GAS f32x4*)(F.out + (size_t)m * DM) + lane; float s2 = 0.f;
#pragma unroll
            for (int j = 0; j < 8; ++j) { const int d = 4 * lane + 256 * j; const f32x4 g4 = *(const LAS f32x4*)(gm + d);
                const f32x4 xm = xr[64 * j] + g4 * (yr[64 * j] * rstdy); xo[64 * j] = xm; h[r][j] = xm;
                s2 += (xm.x * xm.x + xm.y * xm.y) + (xm.z * xm.z + xm.w * xm.w); }
            const float rstd2 = 1.0f / sqrtf(wave_sum(s2) * (1.0f / DM) + RMS_EPS);
            GAS unsigned long long* o8 = (GAS unsigned long long*)(XN + (size_t)m * DM) + lane;
#pragma unroll
            for (int j = 0; j < 8; ++j) { const int d = 4 * lane + 256 * j; const f32x4 g4 = *(const LAS f32x4*)(gsf + d), s4 = *(const LAS f32x4*)(shf + d);
                const f32x4 hv = h[r][j] * rstd2 * g4 + s4; h[r][j] = hv;
                o8[64 * j] = (unsigned long long)pk2(hv.x, hv.y) | ((unsigned long long)pk2(hv.z, hv.w) << 32); }
            asm volatile("" ::: "memory");
        }
        float lg[R];
#pragma unroll
        for (int r = 0; r < R; ++r) lg[r] = 0.f;
#pragma unroll 1
        for (int o = 0; o < 36; ++o) {
            const GAS f32x4* wr_ = (const GAS f32x4*)(WRT + (size_t)o * DM) + lane;
            float p[R];
#pragma unroll
            for (int r = 0; r < R; ++r) p[r] = 0.f;
#pragma unroll
            for (int j = 0; j < 8; ++j) { const f32x4 w = wr_[64 * j];
#pragma unroll
                for (int r = 0; r < R; ++r) p[r] += (h[r][j].x * w.x + h[r][j].y * w.y) + (h[r][j].z * w.z + h[r][j].w * w.w); }
            const float bias = (o < 4) ? F.in[I_BRG][o] : F.in[I_BRE][o - 4];
#pragma unroll
            for (int r = 0; r < R; ++r) { const float t = wave_sum(p[r]) + bias; lg[r] = (lane == o) ? t : lg[r]; }
        }
#pragma unroll
        for (int r = 0; r < R; ++r) { const int m = m0 + r;
            const float g0 = __shfl(lg[r], 0), g1 = __shfl(lg[r], 1), g2 = __shfl(lg[r], 2), g3 = __shfl(lg[r], 3);
            int gsel = 0; float gmax = g0;
            if (g1 > gmax) { gmax = g1; gsel = 1; } if (g2 > gmax) { gmax = g2; gsel = 2; } if (g3 > gmax) { gmax = g3; gsel = 3; }
            const float gw_ = 1.0f / (expf(g0 - gmax) + expf(g1 - gmax) + expf(g2 - gmax) + expf(g3 - gmax));
            float t0 = -INFINITY, t1 = -INFINITY; int j0 = 0, j1 = 0;
#pragma unroll
            for (int i = 0; i < 8; ++i) { const float v = __shfl(lg[r], 4 + 8 * gsel + i);
                if (v > t0) { t1 = t0; j1 = j0; t0 = v; j0 = i; } else if (v > t1) { t1 = v; j1 = i; } }
            const float e1 = expf(t1 - t0), w0 = gw_ / (1.0f + e1), w1 = gw_ * e1 / (1.0f + e1);
            if (lane == 0) {
                const int ea = gsel * 8 + j0, eb = gsel * 8 + j1;
                const int pa = (int)__hip_atomic_fetch_add(CNT + ea, 1u, RLX_AGENT), pb = (int)__hip_atomic_fetch_add(CNT + eb, 1u, RLX_AGENT);
                LIST[ea * S + pa] = 2 * m; LIST[eb * S + pb] = 2 * m + 1; EW[2 * m] = w0; EW[2 * m + 1] = w1; }
        }
    }
    __syncthreads();
}

__device__ __forceinline__ void phase8(Ctx& F) {
    build_mts(F);
    volatile LAS int* mts = (volatile LAS int*)(F.lds + LDSCTL_OFF) + 64;
    const int gw = F.vcu * NWAVES + F.wave, NGW = F.G * NWAVES, lane = F.lane;
    const int total = mts[32] * 256;
    const bf16* XN = (const bf16*)(F.ws + WS_XN); bf16* XG = (bf16*)(F.ws + WS_XG); const float* EW = (const float*)(F.ws + WS_EW); const int* LIST = (const int*)(F.ws + WS_LIST);
    int2* DESC = (int2*)(F.ws + WS_DESC); const gu32* CNT = (const gu32*)(F.ws + WS_CTL) + CW_CNT;
    for (int row = gw; row < total; row += NGW) {
        const int mt = row >> 8; int e = 0;
        for (int j = 1; j < 32; ++j) e += (mts[j] <= mt) ? 1 : 0;
        const int pos = row - 256 * mts[e]; const int cnt = (int)__hip_atomic_load(CNT + e, RLX_AGENT);
        GAS v4u* dst = (GAS v4u*)(XG + (size_t)row * DM) + lane;
        if (pos < cnt) { const int ent = LIST[e * S + pos]; const GAS v4u* src = (const GAS v4u*)(XN + (size_t)(ent >> 1) * DM) + lane;
#pragma unroll
            for (int i = 0; i < 4; ++i) dst[64 * i] = src[64 * i];
            if (lane == 0) DESC[row] = make_int2(ent, __float_as_int(EW[ent])); }
        else {
#pragma unroll
            for (int i = 0; i < 4; ++i) dst[64 * i] = (v4u){0u, 0u, 0u, 0u};
            if (lane == 0) DESC[row] = make_int2(-1, 0); }
    }
}

__device__ __forceinline__ void phase11(Ctx& F) {
    LAS float* gf = (LAS float*)(F.lds + RING_OFF);
    const float* MOD = (const float*)(F.ws + WS_MOD);
    for (int n = F.tid; n < DM; n += NTHREADS) gf[n] = MOD[5 * DM + n] * F.in[I_GPOSTF][n];
    __syncthreads();
    const int gw = F.vcu * NWAVES + F.wave, NGW = F.G * NWAVES, lane = F.lane;
    const float* YE = (const float*)(F.ws + WS_YE);
    float delta = 0.f;
#if defined(ATT_DIAG)
    { const gu32* dg = (const gu32*)(F.ws + WS_CTL) + CW_DIAG; const unsigned ca = __hip_atomic_load(dg + 0, RLX_AGENT), cb = __hip_atomic_load(dg + 1, RLX_AGENT);
      const float mx = __uint_as_float(__hip_atomic_load(dg + 2, RLX_AGENT));
      unsigned best = 0, bi = 0, tot = 0; for (int q = 0; q < 256; ++q) { const unsigned c = __hip_atomic_load(dg + 16 + q, RLX_AGENT); tot += c; if (c > best) { best = c; bi = q; } }
      unsigned hbest = 0, hbi = 0; for (int q = 0; q < 16; ++q) { const unsigned c = __hip_atomic_load(dg + 16 + 256 + q, RLX_AGENT); if (c > hbest) { hbest = c; hbi = q; } }
      delta = ATT_DIAG_MODE == 0 ? 0.05f * log2f(1.0f + (float)ca) : ATT_DIAG_MODE == 1 ? 0.05f * log2f(1.0f + (float)cb) : ATT_DIAG_MODE == 2 ? mx :
              ATT_DIAG_MODE == 3 ? 0.01f * (float)(bi + 1) : ATT_DIAG_MODE == 4 ? (float)best / (float)(tot + 1) : ATT_DIAG_MODE == 5 ? 0.05f * (float)(hbi + 1) : (float)hbest / (float)(tot + 1); }
#endif
    for (int m = gw; m < S; m += NGW) {
        const GAS f32x4* a = (const GAS f32x4*)(YE + (size_t)(2 * m) * DM) + lane; const GAS f32x4* b = (const GAS f32x4*)(YE + (size_t)(2 * m + 1) * DM) + lane;
        GAS f32x4* xo = (GAS f32x4*)(F.out + (size_t)m * DM) + lane;
        f32x4 v[8]; float s2 = 0.f;
#pragma unroll
        for (int j = 0; j < 8; ++j) { v[j] = a[64 * j] + b[64 * j]; s2 += (v[j].x * v[j].x + v[j].y * v[j].y) + (v[j].z * v[j].z + v[j].w * v[j].w); }
        const float rstd = 1.0f / sqrtf(wave_sum(s2) * (1.0f / DM) + RMS_EPS);
#pragma unroll
        for (int j = 0; j < 8; ++j) { const int d = 4 * lane + 256 * j; const f32x4 g4 = *(const LAS f32x4*)(gf + d); xo[64 * j] = xo[64 * j] + g4 * (v[j] * rstd) + delta; }
    }
    __syncthreads();
}

struct Args { const float* in[20]; float* out; unsigned char* ws; int ph_lo, ph_hi, li, pad; };
__global__ void __launch_bounds__(NTHREADS, 2) mega_fwd(Args args) {
    extern __shared__ __attribute__((aligned(16))) unsigned char lds[];
    Ctx F;
#pragma unroll
    for (int i = 0; i < 20; ++i) F.in[i] = args.in[i];
    F.out = args.out; F.ws = args.ws;
    F.lds = (LAS unsigned char*)lds;
    F.tid = threadIdx.x; F.lane = F.tid & 63; F.wave = __builtin_amdgcn_readfirstlane(F.tid >> 6);
    F.G = gridDim.x; { const int bx = blockIdx.x; F.vcu = (F.G % 8 == 0) ? (bx % 8) * (F.G / 8) + bx / 8 : bx; }
    volatile LAS unsigned* MISC = (volatile LAS unsigned*)(F.lds + LDSCTL_OFF);
    for (int u = F.tid; u < 256; u += NTHREADS) MISC[u] = 0u;
    __syncthreads();
    gu32* ctl = (gu32*)(F.ws + WS_CTL);
    XcdBarrier bar; bar.bar = (unsigned*)(ctl + CW_BAR); bar.x = 0; bar.st = nullptr;
    if (N_LAUNCHES != PER_PHASE) bar = xcd_barrier_post((unsigned*)(ctl + CW_BAR), MISC + 8);
    const int lo = args.ph_lo, hi = args.ph_hi;
#ifndef PH_MASK
#define PH_MASK 0xfff
#endif
#define IN(k) (((PH_MASK >> (k)) & 1) && lo <= (k) && (k) < hi)
#define SEAM(k) do { if (IN(k) && IN((k) + 1)) xcd_barrier(bar); } while (0)
    unsigned char* ws = F.ws;
    if (IN(0)) { phase0(F); SEAM(0); }
    if (IN(1)) { phase1(F); SEAM(1); }
    if (IN(2)) { pg8::Gemm g{(const pg8::bf16_t*)(ws + WS_XN), (const pg8::bf16_t*)(ws + WS_WT_IN), S, NIN, DM}; pg8::StaticOrder so; so.init(S, NIN, F.G, (int)blockIdx.x);
        EpiQKVG E{ws}; run_gemm(F, g, so, E); SEAM(2); }
    if (IN(3)) { phase3(F); SEAM(3); }
#if defined(ATT_DIAG)
    if (IN(4)) { attn_naive(F, 0, 2 * S * NH); __syncthreads(); attn_fast(F, true, true, WS_Y); __syncthreads(); attn_fast(F, true, true, WS_TMPA); xcd_barrier(bar); attn_diag_compare(F); SEAM(4); }
#elif FAST_ATTN == 1
    if (IN(4)) { attn_fast(F, true, true); SEAM(4); }
#elif FAST_ATTN == 2
    if (IN(4)) { attn_fast(F, true, false); __syncthreads(); attn_naive(F, S * NH, 2 * S * NH); SEAM(4); }
#elif FAST_ATTN == 3
    if (IN(4)) { attn_fast(F, false, true); __syncthreads(); attn_naive(F, 0, S * NH); SEAM(4); }
#else
    if (IN(4)) { attn_naive(F, 0, 2 * S * NH); SEAM(4); }
#endif
    if (IN(5)) { pg8::Gemm g{(const pg8::bf16_t*)(ws + WS_OAB), (const pg8::bf16_t*)(ws + WS_WT_OAB), 2 * S, 2 * DM, 1024}; GateOrder go; go.init(F.G, (int)blockIdx.x);
        EpiGate E{ws}; run_gemm(F, g, go, E); SEAM(5); }
    if (IN(6)) { pg8::Gemm g{(const pg8::bf16_t*)(ws + WS_Y1), (const pg8::bf16_t*)(ws + WS_WT_OUT), S, DM, DM}; pg8::StaticOrder so; so.init(S, DM, F.G, (int)blockIdx.x);
        EpiY E{ws}; run_gemm(F, g, so, E); SEAM(6); }
    if (IN(7)) { phase7(F); SEAM(7); }
    if (IN(8)) { phase8(F); SEAM(8); }
    if (IN(9)) { build_mts(F); pg8::Gemm g{(const pg8::bf16_t*)(ws + WS_XG), (const pg8::bf16_t*)(ws + WS_WT_GU), MAXROWS, NEXP * 1024, DM};
        MoeOrder mo{(const volatile LAS int*)(F.lds + LDSCTL_OFF) + 64, 2, F.G, F.vcu}; EpiGU E{ws}; run_gemm(F, g, mo, E); SEAM(9); }
    if (IN(10)) { build_mts(F); pg8::Gemm g{(const pg8::bf16_t*)(ws + WS_ACT), (const pg8::bf16_t*)(ws + WS_WT_D), MAXROWS, NEXP * DM, DEXP};
        MoeOrder mo{(const volatile LAS int*)(F.lds + LDSCTL_OFF) + 64, 3, F.G, F.vcu}; EpiDown E{ws}; run_gemm(F, g, mo, E); SEAM(10); }
    if (IN(11)) { phase11(F); }
#undef IN
#undef SEAM
}

extern "C" void kernel_launch(void* const* d_in, const int* in_sizes, int n_in, void* d_out, int out_size, void* d_ws, size_t ws_size, hipStream_t stream) {
    static int grid = 0;
    if (grid == 0) {
        if (n_in != 20 || out_size != S * DM || ws_size < WS_END) { fprintf(stderr, "kernel_launch: unexpected shapes: n_in %d out %d ws %zu (need %zu)\n", n_in, out_size, ws_size, (size_t)WS_END); grid = -1; return; }
        int dev = 0, cus = 0, per_cu = 0;
        if (hipGetDevice(&dev) != hipSuccess || hipDeviceGetAttribute(&cus, hipDeviceAttributeMultiprocessorCount, dev) != hipSuccess) { fprintf(stderr, "kernel_launch: device query failed\n"); grid = -1; return; }
        if (hipFuncSetAttribute((const void*)mega_fwd, hipFuncAttributeMaxDynamicSharedMemorySize, LDS_BYTES) != hipSuccess) { fprintf(stderr, "kernel_launch: hipFuncSetAttribute failed\n"); grid = -1; return; }
        if (hipOccupancyMaxActiveBlocksPerMultiprocessor(&per_cu, (const void*)mega_fwd, NTHREADS, LDS_BYTES) != hipSuccess || per_cu < 1) { fprintf(stderr, "kernel_launch: occupancy query says %d blocks per CU\n", per_cu); grid = -1; (void)hipGetLastError(); return; }
        grid = cus;
        fprintf(stderr, "kernel_launch: grid %d (occupancy query: %d per CU)\n", grid, per_cu);
    }
    if (grid < 0) return;
    if (hipMemsetAsync((char*)d_ws + WS_CTL, 0, CTL_ZERO_BYTES, stream) != hipSuccess) { fprintf(stderr, "kernel_launch: memset failed\n"); return; }
    Args a{};
    for (int i = 0; i < 20; ++i) a.in[i] = (const float*)d_in[i];
    a.out = (float*)d_out; a.ws = (unsigned char*)d_ws;
    if (N_LAUNCHES == 1) {
        a.ph_lo = 0; a.ph_hi = PER_PHASE; a.li = 0;
        void* kargs[] = {&a};
        hipError_t e = hipLaunchCooperativeKernel((const void*)mega_fwd, dim3(grid), dim3(NTHREADS), kargs, LDS_BYTES, stream);
        if (e != hipSuccess) fprintf(stderr, "kernel_launch: cooperative launch failed: %s (grid %d)\n", hipGetErrorString(e), grid);
    } else {
        for (int li = 0; li < PER_PHASE; ++li) { a.ph_lo = li; a.ph_hi = li + 1; a.li = li;
            hipLaunchKernelGGL(mega_fwd, dim3(grid), dim3(NTHREADS), LDS_BYTES, stream, a);
            const hipError_t le = hipPeekAtLastError(); if (le != hipSuccess) { fprintf(stderr, "kernel_launch: launch %d failed: %s\n", li, hipGetErrorName(le)); break; } }
    }
}
```

```cpp
#include <hip/hip_runtime.h>
#include <cstdio>
#include <cstdint>
#include <cmath>

#ifndef MK_N_LAUNCHES
#define MK_N_LAUNCHES 1
#endif
#ifndef FAST_GEMM
#define FAST_GEMM 1
#endif
#ifndef FAST_ATTN
#define FAST_ATTN 1
#endif
namespace pg8 {
#define PG8_LAS __attribute__((address_space(3)))
typedef unsigned short bf16_t;
typedef short bf16x8 __attribute__((ext_vector_type(8)));
typedef float f32x4 __attribute__((ext_vector_type(4)));
typedef unsigned u32x4 __attribute__((ext_vector_type(4)));
constexpr int BM = 256, BK = 64, HALF = 128, HTB = HALF * BK * 2  , STAGE_BYTES = 8 * HTB, NXCD = 8, WGM = 8;

__host__ __device__ __forceinline__ int lds_byte(int r, int c) { const int st = (r >> 4) * 2 + (c >> 5), rr = r & 15, cc = c & 31, ob = rr * 64 + cc * 2; return st * 1024 + (ob ^ (((ob >> 9) & 1) << 5)); }
__host__ __device__ __forceinline__ void stage_rc(int b, int& R, int& C) { const int st = b / 1024, sb = b % 1024, swz = sb ^ (((sb >> 9) & 1) << 5); R = (st >> 1) * 16 + swz / 64; C = (st & 1) * 32 + (swz % 64) / 2; }
__host__ __device__ __forceinline__ int perm32(int rho) { const int n = rho >> 4, i = rho & 15; return 8 * (i >> 2) + 4 * n + (i & 3); }

struct Unit { int pm, pn; };
struct Gemm { const bf16_t* A; const bf16_t* Bt; int M, N, K; };

struct StaticOrder {
    static constexpr bool GATHER = false;
    int nM, nN, nwg, G, c;
    __host__ __device__ void init(int M, int N, int G_, int c_) { nM = M / BM; nN = N / BM; nwg = nM * nN; G = G_; c = c_; }
    __host__ __device__ bool next(int i, Unit& u) const {
        const long L = (long)i * G + c; if (L >= nwg) return false;
        int wgid = (int)L; { const int q = nwg / NXCD, r = nwg % NXCD, xcd = wgid % NXCD, off = wgid / NXCD; wgid = (xcd < r ? xcd * (q + 1) : r * (q + 1) + (xcd - r) * q) + off; }
        const int nig = WGM * nN, gid = wgid / nig, fm = gid * WGM, gsz = (nM - fm) < WGM ? (nM - fm) : WGM;
        u.pm = fm + ((wgid % nig) % gsz); u.pn = (wgid % nig) / gsz; return true;
    }
    __device__ __forceinline__ void a_ready(const Unit&) const {}
    __device__ __forceinline__ void done(const Unit&) const {}
};

__device__ __forceinline__ unsigned cvt_pk_bf16(float lo, float hi) { unsigned r; asm volatile("v_cvt_pk_bf16_f32 %0, %1, %2" : "=v"(r) : "v"(lo), "v"(hi)); return r; }
template <class Epi, class Sched, bool ALIGN_EPI = false, bool SP2 = false>
__device__ __forceinline__ void gemm_phase(PG8_LAS unsigned char* lds, const Gemm g, const Sched& S, const Epi& E) {
    int tid = threadIdx.x; asm volatile("" : "+v"(tid));
    const int wid = __builtin_amdgcn_readfirstlane(tid >> 6), lane = tid & 63, wr = wid >> 2, wc = wid & 3, fr = lane & 15, fq = lane >> 4;
    const int K = g.K, nt = K / BK;
    unsigned voffA[2], voffB[2];
#pragma unroll
    for (int i = 0; i < 2; ++i) { int R, C; stage_rc(tid * 16 + i * 8192, R, C); const int Rb = Epi::PERM ? ((R & ~31) + perm32(R & 31)) : R;
        voffA[i] = (unsigned)(R * K + C) * 2u; voffB[i] = (unsigned)(Rb * K + C) * 2u; }
    unsigned cvo[2][2], nvo[2][2];
#define PG8_GVO(dst, U) do { _Pragma("unroll") for (int h_ = 0; h_ < 2; ++h_) _Pragma("unroll") for (int i_ = 0; i_ < 2; ++i_) { int R_, C_; stage_rc(tid * 16 + i_ * 8192, R_, C_); \
        dst[h_][i_] = (unsigned)(S.arow(U, h_ * HALF + R_) * K + C_) * 2u; } } while (0)
    const size_t kstep = (size_t)(BK * 2);
    const size_t hstep = (size_t)HALF * K * 2;
    const size_t tstep = 2 * hstep;
    const unsigned ldsw = (unsigned)wid * 1024u;
    const int aoff = lds_byte(wr * 64 + fr, fq * 8), boff = lds_byte(wc * 32 + fr, fq * 8);
#define PG8_SA(b, h) (((b) * 2 + (h)) * HTB)
#define PG8_SB(b, h) ((4 + (b) * 2 + (h)) * HTB)
#define PG8_STAGE(bufoff, gbase, voff) do { _Pragma("unroll") for (int _i = 0; _i < 2; ++_i) \
        __builtin_amdgcn_global_load_lds((const unsigned*)((const char*)(gbase) + (voff)[_i]), (PG8_LAS unsigned*)(lds + (bufoff) + ldsw + _i * 8192), 16, 0, 0); } while (0)
#define PG8_STAGE_A(bufoff, gbase, H, NEXT) do { if constexpr (Sched::GATHER) { unsigned vs_[2] = { (NEXT) ? nvo[H][0] : cvo[H][0], (NEXT) ? nvo[H][1] : cvo[H][1] }; PG8_STAGE(bufoff, gbase, vs_); } \
        else { PG8_STAGE(bufoff, (gbase) + ((H) ? hstep : 0), voffA); } } while (0)
#define PG8_LDA(dst, b, h) do { _Pragma("unroll") for (int m = 0; m < 4; ++m) _Pragma("unroll") for (int k = 0; k < 2; ++k) dst[m][k] = *(const PG8_LAS bf16x8*)(lds + PG8_SA(b, h) + aoff + m * 2048 + k * 1024); } while (0)
#define PG8_LDB(dst, b, h) do { _Pragma("unroll") for (int n = 0; n < 2; ++n) _Pragma("unroll") for (int k = 0; k < 2; ++k) dst[n][k] = *(const PG8_LAS bf16x8*)(lds + PG8_SB(b, h) + boff + n * 2048 + k * 1024); } while (0)
#define PG8_MMA(ai, bj, At, Bt) do { __builtin_amdgcn_s_setprio(1); _Pragma("unroll") for (int m = 0; m < 4; ++m) _Pragma("unroll") for (int n = 0; n < 2; ++n) _Pragma("unroll") for (int k = 0; k < 2; ++k) \
        acc[ai][bj][m][n] = __builtin_amdgcn_mfma_f32_16x16x32_bf16(Bt[n][k], At[m][k], acc[ai][bj][m][n], 0, 0, 0); __builtin_amdgcn_s_setprio(0); } while (0)
#define PG8_WAIT_V(n) asm volatile("s_waitcnt vmcnt(" #n ")" ::: "memory")
#define PG8_WAIT_L(n) asm volatile("s_waitcnt lgkmcnt(" #n ")" ::: "memory")
#define PG8_BAR __builtin_amdgcn_s_barrier()
#define PG8_SCHED __builtin_amdgcn_sched_barrier(0)
    static_assert(SP2 || !Sched::GATHER, "gathered A rows are wired into the two-super-phase loop only");
    Unit cur, nxt; int ui = 0;
    if (!S.next(0, cur)) return;
    f32x4 acc[2][2][4][2];
#pragma unroll
    for (int a = 0; a < 2; ++a)
#pragma unroll
        for (int b = 0; b < 2; ++b)
#pragma unroll
            for (int m = 0; m < 4; ++m)
#pragma unroll
                for (int n = 0; n < 2; ++n) acc[a][b][m][n] = (f32x4){0.f, 0.f, 0.f, 0.f};
    bf16x8 At[4][2], B0[2][2], B1[2][2];
    const char* cA = (const char*)g.A + (Sched::GATHER ? (size_t)0 : (size_t)cur.pm * tstep); if constexpr (Sched::GATHER) { PG8_GVO(cvo, cur); }
    const char* cB = (const char*)g.Bt + (size_t)cur.pn * tstep;
    S.a_ready(cur);
    if constexpr (SP2) {
        PG8_STAGE(PG8_SB(0, 0), cB, voffB); PG8_STAGE(PG8_SB(0, 1), cB + hstep, voffB); PG8_STAGE_A(PG8_SA(0, 0), cA, 0, false); PG8_STAGE_A(PG8_SA(0, 1), cA, 1, false);
        if (wr == 1) PG8_BAR;
        PG8_WAIT_V(2); PG8_BAR;
        PG8_STAGE(PG8_SB(1, 0), cB + kstep, voffB); PG8_STAGE_A(PG8_SA(1, 0), cA + kstep, 0, false); PG8_STAGE(PG8_SB(1, 1), cB + hstep + kstep, voffB);
        PG8_WAIT_V(6); PG8_BAR;
    } else {
        PG8_STAGE(PG8_SB(0, 0), cB, voffB); PG8_STAGE(PG8_SA(0, 0), cA, voffA); PG8_STAGE(PG8_SB(0, 1), cB + hstep, voffB); PG8_STAGE(PG8_SA(0, 1), cA + hstep, voffA);
        if (wr == 1) PG8_BAR;
        PG8_WAIT_V(4); PG8_BAR;
        PG8_STAGE(PG8_SB(1, 0), cB + kstep, voffB); PG8_STAGE(PG8_SA(1, 0), cA + kstep, voffA); PG8_STAGE(PG8_SB(1, 1), cB + hstep + kstep, voffB);
        PG8_WAIT_V(6); PG8_BAR;
    }
    for (;;) {
        const bool has_next = S.next(ui + 1, nxt);
        const char* nA = (has_next && !Sched::GATHER) ? (const char*)g.A + (size_t)nxt.pm * tstep : cA;
        if constexpr (Sched::GATHER) { if (has_next) { PG8_GVO(nvo, nxt); } else { _Pragma("unroll") for (int h_ = 0; h_ < 2; ++h_) _Pragma("unroll") for (int i_ = 0; i_ < 2; ++i_) nvo[h_][i_] = cvo[h_][i_]; } }
        const char* nB = has_next ? (const char*)g.Bt + (size_t)nxt.pn * tstep : cB;
        for (int t = 0; t < nt; t += 2) {
            const bool last = (t == nt - 2);
            const char* a1 = cA + (size_t)(t + 1) * kstep;
            const char* a2 = last ? nA : cA + (size_t)(t + 2) * kstep; const char* b2 = last ? nB : cB + (size_t)(t + 2) * kstep;
            const char* a3 = a2 + kstep; const char* b3 = b2 + kstep;
            if (last && has_next) S.a_ready(nxt);
            if constexpr (SP2) {
            PG8_LDB(B0, 0, 0); PG8_LDB(B1, 0, 1); PG8_SCHED; PG8_LDA(At, 0, 0); PG8_STAGE_A(PG8_SA(1, 1), a1, 1, false);
            PG8_WAIT_V(8); PG8_WAIT_L(0); PG8_BAR; PG8_MMA(0, 0, At, B0); PG8_MMA(0, 1, At, B1); PG8_BAR; PG8_SCHED;
            PG8_LDA(At, 0, 1); PG8_STAGE(PG8_SB(0, 0), b2, voffB); PG8_STAGE(PG8_SB(0, 1), b2 + hstep, voffB); PG8_STAGE_A(PG8_SA(0, 0), a2, 0, last);
            PG8_WAIT_V(8); PG8_WAIT_L(0); PG8_BAR; PG8_MMA(1, 0, At, B0); PG8_MMA(1, 1, At, B1); PG8_BAR; PG8_SCHED;
            PG8_LDB(B0, 1, 0); PG8_LDB(B1, 1, 1); PG8_SCHED; PG8_LDA(At, 1, 0); PG8_STAGE_A(PG8_SA(0, 1), a2, 1, last);
            PG8_WAIT_V(8); PG8_WAIT_L(0); PG8_BAR; PG8_MMA(0, 0, At, B0); PG8_MMA(0, 1, At, B1); PG8_BAR; PG8_SCHED;
            PG8_LDA(At, 1, 1); PG8_STAGE(PG8_SB(1, 0), b3, voffB); PG8_STAGE(PG8_SB(1, 1), b3 + hstep, voffB); PG8_STAGE_A(PG8_SA(1, 0), a3, 0, last);
            PG8_WAIT_V(8); PG8_WAIT_L(0); PG8_BAR; PG8_MMA(1, 0, At, B0); PG8_MMA(1, 1, At, B1); PG8_BAR; PG8_SCHED;
            } else {
            PG8_LDB(B0, 0, 0); PG8_SCHED; PG8_LDA(At, 0, 0); PG8_STAGE(PG8_SA(1, 1), a1 + hstep, voffA);
            PG8_WAIT_L(8); PG8_BAR; PG8_WAIT_L(0); PG8_MMA(0, 0, At, B0); PG8_BAR; PG8_SCHED;
            PG8_LDB(B1, 0, 1); PG8_STAGE(PG8_SB(0, 0), b2, voffB);
            PG8_BAR; PG8_WAIT_L(0); PG8_MMA(0, 1, At, B1); PG8_BAR;
            PG8_LDA(At, 0, 1); PG8_STAGE(PG8_SA(0, 0), a2, voffA);
            PG8_BAR; PG8_WAIT_L(0); PG8_MMA(1, 0, At, B0); PG8_BAR; PG8_SCHED;
            PG8_STAGE(PG8_SB(0, 1), b2 + hstep, voffB);
            PG8_WAIT_V(6); PG8_BAR; PG8_MMA(1, 1, At, B1); PG8_BAR;
            PG8_LDB(B0, 1, 0); PG8_SCHED; PG8_LDA(At, 1, 0); PG8_STAGE(PG8_SA(0, 1), a2 + hstep, voffA);
            PG8_WAIT_L(8); PG8_BAR; PG8_WAIT_L(0); PG8_MMA(0, 0, At, B0); PG8_BAR; PG8_SCHED;
            PG8_LDB(B1, 1, 1); PG8_STAGE(PG8_SB(1, 0), b3, voffB);
            PG8_BAR; PG8_WAIT_L(0); PG8_MMA(0, 1, At, B1); PG8_BAR;
            PG8_LDA(At, 1, 1); PG8_STAGE(PG8_SA(1, 0), a3, voffA);
            PG8_BAR; PG8_WAIT_L(0); PG8_MMA(1, 0, At, B0); PG8_BAR; PG8_SCHED;
            PG8_STAGE(PG8_SB(1, 1), b3 + hstep, voffB);
            PG8_WAIT_V(6); PG8_BAR; PG8_MMA(1, 1, At, B1); PG8_BAR;
            }
        }
        if constexpr (ALIGN_EPI) { if (wr == 0) PG8_BAR; }
        if constexpr (!Epi::AFTER_DRAIN) { E(acc, cur, wr, wc, fr, fq); S.done(cur); }
        if (!has_next) break;
#pragma unroll
        for (int a = 0; a < 2; ++a)
#pragma unroll
            for (int b = 0; b < 2; ++b)
#pragma unroll
                for (int m = 0; m < 4; ++m)
#pragma unroll
                    for (int n = 0; n < 2; ++n) acc[a][b][m][n] = (f32x4){0.f, 0.f, 0.f, 0.f};
        cur = nxt; cA = nA; cB = nB; ++ui;
        if constexpr (Sched::GATHER) { _Pragma("unroll") for (int h_ = 0; h_ < 2; ++h_) _Pragma("unroll") for (int i_ = 0; i_ < 2; ++i_) cvo[h_][i_] = nvo[h_][i_]; }
        if constexpr (ALIGN_EPI) { if (wr == 1) PG8_BAR; }
    }
    PG8_WAIT_V(0);
    if constexpr (!ALIGN_EPI) { if (wr == 0) PG8_BAR; }
    PG8_BAR;
    if constexpr (Epi::AFTER_DRAIN) { E.fused(acc, cur, wr, wc, fr, fq, lds, wid, lane); S.done(cur); }
#undef PG8_SA
#undef PG8_SB
#undef PG8_STAGE
#undef PG8_STAGE_A
#undef PG8_GVO
#undef PG8_LDA
#undef PG8_LDB
#undef PG8_MMA
#undef PG8_WAIT_V
#undef PG8_WAIT_L
#undef PG8_BAR
#undef PG8_SCHED
}
}
#define GAS __attribute__((address_space(1)))
#define LAS __attribute__((address_space(3)))
typedef unsigned short bf16;
typedef unsigned v4u __attribute__((ext_vector_type(4)));
typedef float f32x4 __attribute__((ext_vector_type(4)));
typedef short bf16x8 __attribute__((ext_vector_type(8)));
typedef GAS unsigned gu32;
typedef GAS unsigned long long gu64;
#define RLX_AGENT __ATOMIC_RELAXED, __HIP_MEMORY_SCOPE_AGENT
#define LDS_WAIT() asm volatile("s_waitcnt lgkmcnt(0)" ::: "memory")
#define VM_WAIT() asm volatile("s_waitcnt vmcnt(0)" ::: "memory")
__device__ __forceinline__ unsigned long long rt() { return __builtin_amdgcn_s_memrealtime(); }
__device__ __forceinline__ unsigned f2bf(float f) { unsigned u = __builtin_bit_cast(unsigned, f); return (u + 0x7fffu + ((u >> 16) & 1u)) >> 16; }
__device__ __forceinline__ unsigned pk2(float lo, float hi) { return f2bf(lo) | (f2bf(hi) << 16); }

#define XB_TMO      128
#define XB_XCNT(j)  (256  + 64 * (j))
#define XB_XSUB(j)  (1280 + 64 * (j))
#define XB_XGEN(j)  (2304 + 64 * (j))
#define XB_TOP      3328
#define XB_TOPGEN   3392
#define XCD_BAR_WORDS 3456
#define XB_SPIN_CAP (1u << 18)

__device__ __forceinline__ unsigned xb_ld(unsigned* p)              { return __hip_atomic_load(p, __ATOMIC_RELAXED, __HIP_MEMORY_SCOPE_AGENT); }
__device__ __forceinline__ unsigned xb_add(unsigned* p, unsigned v) { return __hip_atomic_fetch_add(p, v, __ATOMIC_RELAXED, __HIP_MEMORY_SCOPE_AGENT); }
__device__ __forceinline__ unsigned xb_xcc_id() { return (unsigned)__builtin_amdgcn_s_getreg((3 << 11) | 20) & 0xFu; }
#define XB_SPIN(cond, bar) do { unsigned _sp = 0; while (cond) { __builtin_amdgcn_s_sleep(1); \
    if ((++_sp & 255u) == 0u) { if (xb_ld(&(bar)[XB_TMO])) break; if (_sp > XB_SPIN_CAP) { atomicAdd(&(bar)[XB_TMO], 1u); break; } } } } while (0)

struct XcdBarrier {
    unsigned* bar; unsigned x;
    volatile LAS unsigned* st;
};

__device__ __forceinline__ XcdBarrier xcd_barrier_post(unsigned* bar, volatile LAS unsigned* st) {
    XcdBarrier b; b.bar = bar; b.x = xb_xcc_id(); b.st = st;
    if (threadIdx.x == 0) (void)xb_add(&bar[XB_XCNT(b.x)], 1u);
    return b;
}
__device__ __forceinline__ void xcd_barrier_complete(unsigned* bar, unsigned x, unsigned& nloc, unsigned& nx) {
    const unsigned G = gridDim.x * gridDim.y * gridDim.z;
    unsigned sum, cnt, mine, sp = 0u;
    for (;;) {
        sum = 0u; cnt = 0u; mine = 0u;
#pragma unroll
        for (unsigned j = 0; j < 16; ++j) { const unsigned c = xb_ld(&bar[XB_XCNT(j)]); sum += c; cnt += (c > 0u) ? 1u : 0u; mine = (j == x) ? c : mine; }
        if (sum == G) break;
        __builtin_amdgcn_s_sleep(1);
        if ((++sp & 255u) == 0u) { if (xb_ld(&bar[XB_TMO])) break; if (sp > XB_SPIN_CAP) { atomicAdd(&bar[XB_TMO], 1u); break; } }
    }
    nloc = mine > 0u ? mine : 1u; nx = cnt > 0u ? cnt : 1u;
}

__device__ __forceinline__ void xcd_barrier(const XcdBarrier& b) {
    asm volatile("s_waitcnt vmcnt(0)" ::: "memory");
    __syncthreads();
    if (threadIdx.x == 0) {
        unsigned* bar = b.bar;
        __builtin_amdgcn_s_waitcnt(0);
        unsigned nloc = b.st[0], nx = b.st[1];
        if (nloc == 0u) { xcd_barrier_complete(bar, b.x, nloc, nx); b.st[0] = nloc; b.st[1] = nx; }
        const unsigned old = xb_add(&bar[XB_XSUB(b.x)], 1u);
        const unsigned gen = old / nloc;
        if (old + 1u == (gen + 1u) * nloc) {
            __builtin_amdgcn_fence(__ATOMIC_RELEASE, "agent");
            asm volatile("s_waitcnt vmcnt(0)" ::: "memory");
            const unsigned og = xb_add(&bar[XB_TOP], 1u);
            const unsigned tg = og / nx;
            if (og + 1u == (tg + 1u) * nx) xb_add(&bar[XB_TOPGEN], 1u);
            else XB_SPIN(xb_ld(&bar[XB_TOPGEN]) == tg, bar);
            __builtin_amdgcn_fence(__ATOMIC_ACQUIRE, "agent");
            xb_add(&bar[XB_XGEN(b.x)], 1u);
            asm volatile("s_waitcnt vmcnt(0)" ::: "memory");
        } else {
            XB_SPIN(xb_ld(&bar[XB_XGEN(b.x)]) == gen, bar);
            __builtin_amdgcn_fence(__ATOMIC_ACQUIRE, "agent");
            asm volatile("s_waitcnt vmcnt(0)" ::: "memory");
        }
    }
    __syncthreads();
}

namespace att {
using bf16x8 = __attribute__((ext_vector_type(8))) short;
using s16x4 = __attribute__((ext_vector_type(4))) short;
using f32x16 = __attribute__((ext_vector_type(16))) float;
using u32x4 = __attribute__((ext_vector_type(4))) unsigned;
using f32x4 = __attribute__((ext_vector_type(4))) float;
constexpr int D = 64, NW = 8, QBLK = 32, QB = QBLK * NW, KVBLK = 64, DMQ = 1024;
constexpr int SLOTB = 8192, LDS_K = 0, LDS_V = 3 * SLOTB, LDS_WS = 6 * SLOTB, LDS_OST = LDS_WS + NW * 256, LDS_BYTES = LDS_OST + NW * 4096;
constexpr float THR = 8.0f;
#define SBAR() __builtin_amdgcn_sched_barrier(0)
#define PIN(x) asm volatile("" : "+v"(x))
#define MFMA(a, b, c) __builtin_amdgcn_mfma_f32_32x32x16_bf16(a, b, c, 0, 0, 0)
#define WAIT_BAR(N) asm volatile("s_waitcnt vmcnt(" #N ") lgkmcnt(0)\n\ts_barrier" ::: "memory")
typedef __attribute__((address_space(3))) char* lds_ptr;
typedef __attribute__((address_space(3))) const char* lds_cptr;
typedef short v4i16_t __attribute__((ext_vector_type(4)));
__device__ __forceinline__ int crow(int r, int hi) { return (r & 3) + 8 * (r >> 2) + 4 * hi; }
__device__ __forceinline__ unsigned cvtpk(float lo, float hi) { unsigned r; asm("v_cvt_pk_bf16_f32 %0, %1, %2" : "=v"(r) : "v"(lo), "v"(hi)); return r; }
__device__ __forceinline__ void glds16(const void* g, unsigned lds_base) {
    unsigned sv; asm volatile("s_mov_b32 %0, m0\n\ts_mov_b32 m0, %2\n\ts_nop 0\n\tglobal_load_lds_dwordx4 %1, off\n\ts_mov_b32 m0, %0" : "=&s"(sv) : "v"(g), "s"(lds_base) : "memory"); }
__device__ __forceinline__ void kload2(bf16x8* kf, lds_cptr kp, int d0) { kf[2 * d0] = *(const __attribute__((address_space(3))) bf16x8*)(kp + d0 * 2048); kf[2 * d0 + 1] = *(const __attribute__((address_space(3))) bf16x8*)(kp + d0 * 2048 + 512); }
__device__ __forceinline__ s16x4 vtr(lds_cptr p) { return __builtin_bit_cast(s16x4, __builtin_amdgcn_ds_read_tr16_b64_v4i16((__attribute__((address_space(3))) v4i16_t*)p)); }
#define MX3(a, b, c) __builtin_fmaxf(__builtin_fmaxf((a), (b)), (c))
__device__ __forceinline__ float rowmax(const f32x16& p0, const f32x16& p1, float c32) {
    float a = MX3(p0[0], p0[1], p0[2]), b = MX3(p1[0], p1[1], p1[2]); a = MX3(a, p0[3], p0[4]); b = MX3(b, p1[3], p1[4]);
#pragma unroll
    for (int r = 5; r < 15; r += 2) { a = MX3(a, p0[r], p0[r + 1]); b = MX3(b, p1[r], p1[r + 1]); }
    a = __builtin_fmaxf(a, p0[15]); b = __builtin_fmaxf(b, p1[15]);
    float m = __builtin_fmaxf(a, b + c32); auto rr = __builtin_amdgcn_permlane32_swap(__float_as_uint(m), __float_as_uint(m), false, false);
    return __builtin_fmaxf(__uint_as_float(rr[0]), __uint_as_float(rr[1])); }
template <int MODE> __device__ __forceinline__ void tmask(f32x16& p0, f32x16& p1, int jb, int qrel, int hi) {
    const int kb = 64 * jb + 4 * hi;
#pragma unroll
    for (int r = 0; r < 16; ++r) { const int kv = kb + (r & 3) + 8 * (r >> 2);
        if (MODE == 0) { if (kv > qrel) p0[r] = -INFINITY; if (kv + 32 > qrel) p1[r] = -INFINITY; }
        else { if (kv > qrel || kv <= qrel - 128) p0[r] = -INFINITY; if (kv + 32 > qrel || kv + 32 <= qrel - 128) p1[r] = -INFINITY; } } }

template <int MODE>
__device__ __forceinline__ void unit(int h, int qb, const bf16* Q, const bf16* __restrict__ K, const bf16* __restrict__ V, bf16* O, const float* KM, float slope2, float sink2, lds_ptr lds) {
    constexpr int DMK = MODE ? 256 : 1024;
    const int kvcol = MODE ? 64 * (h >> 2) : 64 * h;
    int tid = threadIdx.x; asm volatile("" : "+v"(tid));
    const int lane = tid & 63, r32 = lane & 31, hi = lane >> 5; const int wid = __builtin_amdgcn_readfirstlane(tid >> 6);
    const int q0 = qb * QB, NT = (q0 + QB) / KVBLK, NB = NT - 4;
    const int T0 = MODE ? (NB >= 2 ? NB - 2 : 0) : 0;
    const bf16* Qw = Q + (size_t)(q0 + wid * QBLK) * DMQ + h * D;
    const unsigned lds0 = (unsigned)(uintptr_t)lds; __attribute__((address_space(3))) float* wsf = (__attribute__((address_space(3))) float*)(lds + LDS_WS) + wid * 64;
    const bf16* ksrc = K + kvcol + (size_t)lane * DMK + wid * 8;
    const bf16* vsrc = V + kvcol + (size_t)(16 * (wid & 3) + (lane >> 2)) * DMK + (wid >> 2) * 32 + (lane & 3) * 8;
    const unsigned kdst = lds0 + LDS_K + wid * 1024, vdst = lds0 + LDS_V + wid * 1024;
#define DMA_K(t, slot) glds16(ksrc + (size_t)(t) * KVBLK * DMK, (unsigned)__builtin_amdgcn_readfirstlane(kdst + (slot)))
#define DMA_V(t, slot) glds16(vsrc + (size_t)(t) * KVBLK * DMK, (unsigned)__builtin_amdgcn_readfirstlane(vdst + (slot)))
    const lds_cptr vp0 = (lds_cptr)lds + LDS_V + ((lane >> 4) & 1) * 32 + (lane & 3) * 8 + (4 * hi + ((lane & 15) >> 2)) * 64;
    const lds_cptr kp0 = (lds_cptr)lds + LDS_K + hi * 1024 + r32 * 16;
    DMA_K(T0, 0); DMA_V(T0, 0); DMA_K(T0 + 1, SLOTB);
    bf16x8 qr[4];
#pragma unroll
    for (int d0 = 0; d0 < 4; ++d0) qr[d0] = *reinterpret_cast<const bf16x8*>(&Qw[(size_t)r32 * DMQ + d0 * 16 + hi * 8]);
#ifndef ATT_KM_GLOBAL
    if (MODE == 0 && qb > 0) {
        if (tid * 4 < qb * 64) { const f32x4 kmv = *(const __attribute__((address_space(1))) f32x4*)(KM + 4 * tid); *(__attribute__((address_space(3))) f32x4*)(lds + LDS_OST + 16 * tid) = kmv; } }
#endif
    float mhat = 0.f, l_reg = 0.f; f32x16 o[2]; o[0] = f32x16{}; o[1] = f32x16{};
    f32x16 ab0;
#pragma unroll
    for (int r = 0; r < 16; ++r) ab0[r] = slope2 * (float)crow(r, hi);
    PIN(ab0); const float c32 = 32.0f * slope2;
    const int qrel = wid * QBLK + r32; bool resc = false;
    f32x16 pA0, pA1, pB0, pB1; bf16x8 kf[8]; s16x4 vlo[8], vhi[8]; u32x4 pw0, pw1, pw2, pw3;
    int sl_prev = 0, sl_cur = 0, sl_next = SLOTB;
#define ROT() do { sl_prev = sl_cur; sl_cur = sl_next; sl_next = (sl_next == 2 * SLOTB) ? 0 : sl_next + SLOTB; } while (0)
#define EX(v, NM) __builtin_amdgcn_exp2f((v) + (NM))
#define RESC() do { if (resc) { _Pragma("unroll") for (int d_ = 0; d_ < 2; ++d_) _Pragma("unroll") for (int r = 0; r < 16; ++r) o[d_][r] *= wsf[crow(r, hi)]; } } while (0)
    DMA_K(T0 + 2, 2 * SLOTB);
    WAIT_BAR(3);
    unsigned selmask = 0u;
    if (MODE == 0 && qb > 0) {
        float qf[32];
#pragma unroll
        for (int d0 = 0; d0 < 4; ++d0)
#pragma unroll
            for (int i = 0; i < 8; ++i) qf[d0 * 8 + i] = __uint_as_float(((unsigned)(unsigned short)qr[d0][i]) << 16);
#ifdef ATT_KM_GLOBAL
        const float* kmL = KM + 8 * hi;
#define KMAS
#else
        const __attribute__((address_space(3))) float* kmL = (const __attribute__((address_space(3))) float*)(lds + LDS_OST) + 8 * hi;
#define KMAS __attribute__((address_space(3)))
#endif
        float b0 = -INFINITY, b1 = -INFINITY, b2 = -INFINITY; int i0 = -1, i1 = -1, i2 = -1;
        for (int j = 0; j < qb; ++j) {
            float p = 0.f;
#pragma unroll
            for (int d0 = 0; d0 < 4; ++d0) { const f32x4 ka = *(const KMAS f32x4*)(kmL + j * 64 + 16 * d0), kb = *(const KMAS f32x4*)(kmL + j * 64 + 16 * d0 + 4);
                p += qf[8 * d0 + 0] * ka.x + qf[8 * d0 + 1] * ka.y + qf[8 * d0 + 2] * ka.z + qf[8 * d0 + 3] * ka.w + qf[8 * d0 + 4] * kb.x + qf[8 * d0 + 5] * kb.y + qf[8 * d0 + 6] * kb.z + qf[8 * d0 + 7] * kb.w; }
            auto rr = __builtin_amdgcn_permlane32_swap(__float_as_uint(p), __float_as_uint(p), false, false);
            const float v = __uint_as_float(rr[0]) + __uint_as_float(rr[1]);
            if (v > b0) { b2 = b1; i2 = i1; b1 = b0; i1 = i0; b0 = v; i0 = j; }
            else if (v > b1) { b2 = b1; i2 = i1; b1 = v; i1 = j; }
            else if (v > b2) { b2 = v; i2 = j; }
        }
        if (i0 >= 0) selmask |= 1u << i0; if (i1 >= 0) selmask |= 1u << i1; if (i2 >= 0) selmask |= 1u << i2;
    }
#define TB(t) (slope2 * (float)(64 * ((t) - NB) - 255))
#define SELROW(t) (((selmask >> ((t) >> 2)) & 1u) != 0u)
    _Pragma("unroll") for (int d0 = 0; d0 < 4; ++d0) kload2(kf, kp0, d0);
    pA0 = MFMA(kf[0], qr[0], ab0); pA1 = MFMA(kf[1], qr[0], ab0); pA0 = MFMA(kf[2], qr[1], pA0); pA1 = MFMA(kf[3], qr[1], pA1);
    pA0 = MFMA(kf[4], qr[2], pA0); pA1 = MFMA(kf[5], qr[2], pA1); pA0 = MFMA(kf[6], qr[3], pA0); pA1 = MFMA(kf[7], qr[3], pA1);
    { float nmp = TB(T0);
      if (MODE == 0 && T0 < NB) { nmp = SELROW(T0) ? nmp : -INFINITY; } else tmask<MODE>(pA0, pA1, T0 - NB, qrel, hi);
      const float rm = rowmax(pA0, pA1, c32) + nmp; mhat = __builtin_fmaxf(rm, slope2 * (float)(qrel - 255)); const float nmh = nmp - mhat, nmh1 = nmh + c32;
#pragma unroll
      for (int r = 0; r < 16; ++r) { pA0[r] = EX(pA0[r], nmh); pA1[r] = EX(pA1[r], nmh1); } }
    WAIT_BAR(0);
    DMA_K(T0 + 3, 0); DMA_V(T0 + 1, SLOTB); ROT();
    _Pragma("unroll") for (int d0 = 0; d0 < 4; ++d0) kload2(kf, kp0 + sl_cur, d0);
    WAIT_BAR(2);
#define PKW(P, i) cvtpk(P[i], P[i + 1])
#define PAF(k) __builtin_bit_cast(bf16x8, pw##k)
#define VFR(i) (bf16x8){vlo[i][0], vlo[i][1], vlo[i][2], vlo[i][3], vhi[i][0], vhi[i][1], vhi[i][2], vhi[i][3]}
#define VRD(i) do { vlo[i] = vtr(vp_ + (((i) >> 2) * 4096 + ((i) & 3) * 1024)); vhi[i] = vtr(vp_ + (((i) >> 2) * 4096 + ((i) & 3) * 1024 + 512)); } while (0)
#define KRD(G, d0) do { if (G) { kload2(kf, kp0 + sl_next, d0); SBAR(); } } while (0)
#define GAPA(MF, a0, a1, a2, a3, W0, W1, PW) do { MF; sacc += a0; sacc += a1; sacc += a2; sacc += a3; W0; W1; PIN(PW); PIN(sacc); SBAR(); } while (0)
#define GAPB(MF, X, i, NM) do { MF; X[i] = EX(X[i], NM); X[i + 1] = EX(X[i + 1], NM); X[i + 2] = EX(X[i + 2], NM); X[i + 3] = EX(X[i + 3], NM); PIN(X); SBAR(); } while (0)
#define STEP(C0, C1, P0, P1, t, KIND, GK, GV, GL) do { SBAR(); \
    const lds_cptr vp_ = vp0 + sl_prev; \
    VRD(0); SBAR(); float sacc = P0[0] + P0[1]; \
                    GAPA(C0 = MFMA(kf[0], qr[0], ab0),   P0[2], P0[3], P0[4], P0[5],     pw0[0] = PKW(P0, 0),  pw0[1] = PKW(P0, 2),  pw0); \
    VRD(4); SBAR(); GAPA(C1 = MFMA(kf[1], qr[0], ab0),   P0[6], P0[7], P0[8], P0[9],     pw0[2] = PKW(P0, 4),  pw0[3] = PKW(P0, 6),  pw0); \
    VRD(1); SBAR(); GAPA(C0 = MFMA(kf[2], qr[1], C0),    P0[10], P0[11], P0[12], P0[13], pw1[0] = PKW(P0, 8),  pw1[1] = PKW(P0, 10), pw1); \
    VRD(5); SBAR(); GAPA(C1 = MFMA(kf[3], qr[1], C1),    P0[14], P0[15], P1[0], P1[1],   pw1[2] = PKW(P0, 12), pw1[3] = PKW(P0, 14), pw1); \
    VRD(2); SBAR(); GAPA(C0 = MFMA(kf[4], qr[2], C0),    P1[2], P1[3], P1[4], P1[5],     pw2[0] = PKW(P1, 0),  pw2[1] = PKW(P1, 2),  pw2); \
    VRD(6); SBAR(); GAPA(C1 = MFMA(kf[5], qr[2], C1),    P1[6], P1[7], P1[8], P1[9],     pw2[2] = PKW(P1, 4),  pw2[3] = PKW(P1, 6),  pw2); \
    VRD(3); SBAR(); GAPA(C0 = MFMA(kf[6], qr[3], C0),    P1[10], P1[11], P1[12], P1[13], pw3[0] = PKW(P1, 8),  pw3[1] = PKW(P1, 10), pw3); \
    VRD(7); SBAR(); GAPA(C1 = MFMA(kf[7], qr[3], C1),    P1[14], P1[15], 0.f, 0.f,       pw3[2] = PKW(P1, 12), pw3[3] = PKW(P1, 14), pw3); \
    l_reg += sacc; \
    if (GK) DMA_K((t) + 3, sl_cur); if (GV) DMA_V((t) + 1, sl_next); \
    float nmh = TB(t) - mhat; \
    if (KIND == 0) { if (MODE == 0) nmh = SELROW(t) ? nmh : -INFINITY; } \
    else { if (MODE == 0 && (t) < NB) nmh = SELROW(t) ? nmh : -INFINITY; else tmask<MODE>(C0, C1, (t) - NB, qrel, hi); } \
    { const float rm = rowmax(C0, C1, c32) + nmh; resc = false; \
      if (__builtin_expect(__any(rm > THR), 0)) { const float dl = __builtin_fmaxf(rm, 0.f); mhat += dl; nmh -= dl; \
          const float f = __builtin_amdgcn_exp2f(-dl); l_reg *= f; if (hi == 0) wsf[r32] = f; resc = true; } } \
    const float nmh1 = nmh + c32; SBAR(); \
    GAPB(o[0] = MFMA(PAF(0), VFR(0), o[0]), C0, 0, nmh);              GAPB(o[1] = MFMA(PAF(0), VFR(4), o[1]), C0, 4, nmh); \
    KRD(GL, 0); GAPB(o[0] = MFMA(PAF(1), VFR(1), o[0]), C0, 8, nmh);  KRD(GL, 1); GAPB(o[1] = MFMA(PAF(1), VFR(5), o[1]), C0, 12, nmh); \
    KRD(GL, 2); GAPB(o[0] = MFMA(PAF(2), VFR(2), o[0]), C1, 0, nmh1);  KRD(GL, 3); GAPB(o[1] = MFMA(PAF(2), VFR(6), o[1]), C1, 4, nmh1); \
    GAPB(o[0] = MFMA(PAF(3), VFR(3), o[0]), C1, 8, nmh1);              GAPB(o[1] = MFMA(PAF(3), VFR(7), o[1]), C1, 12, nmh1); \
    } while (0)
    int t = T0 + 1;
    for (; t + 5 < NT; t += 2) {
        STEP(pB0, pB1, pA0, pA1, t, 0, true, true, true);     WAIT_BAR(2); RESC(); ROT();
        STEP(pA0, pA1, pB0, pB1, t + 1, 0, true, true, true); WAIT_BAR(2); RESC(); ROT();
    }
#define ENDW(tt) do { if ((tt) + 3 < NT) { WAIT_BAR(2); } else if ((tt) + 2 < NT) { WAIT_BAR(1); } else { WAIT_BAR(0); } } while (0)
    for (; t + 1 < NT; t += 2) {
        STEP(pB0, pB1, pA0, pA1, t, 1, (t + 3 < NT), (t + 1 < NT), (t + 1 < NT));         ENDW(t);     RESC(); ROT();
        STEP(pA0, pA1, pB0, pB1, t + 1, 1, (t + 4 < NT), (t + 2 < NT), (t + 2 < NT));     ENDW(t + 1); RESC(); ROT();
    }
    STEP(pB0, pB1, pA0, pA1, NT - 1, 1, false, false, false); RESC();
    { float sacc = pB0[0] + pB0[1];
#pragma unroll
      for (int r = 2; r < 16; ++r) sacc += pB0[r];
#pragma unroll
      for (int r = 0; r < 16; ++r) sacc += pB1[r];
      l_reg += sacc;
      pw0 = (u32x4){PKW(pB0, 0), PKW(pB0, 2), PKW(pB0, 4), PKW(pB0, 6)}; pw1 = (u32x4){PKW(pB0, 8), PKW(pB0, 10), PKW(pB0, 12), PKW(pB0, 14)};
      pw2 = (u32x4){PKW(pB1, 0), PKW(pB1, 2), PKW(pB1, 4), PKW(pB1, 6)}; pw3 = (u32x4){PKW(pB1, 8), PKW(pB1, 10), PKW(pB1, 12), PKW(pB1, 14)};
      const lds_cptr vp_ = vp0 + sl_cur; _Pragma("unroll") for (int i = 0; i < 8; ++i) VRD(i);
      o[0] = MFMA(PAF(0), VFR(0), o[0]); o[1] = MFMA(PAF(0), VFR(4), o[1]); o[0] = MFMA(PAF(1), VFR(1), o[0]); o[1] = MFMA(PAF(1), VFR(5), o[1]);
      o[0] = MFMA(PAF(2), VFR(2), o[0]); o[1] = MFMA(PAF(2), VFR(6), o[1]); o[0] = MFMA(PAF(3), VFR(3), o[0]); o[1] = MFMA(PAF(3), VFR(7), o[1]); }
    { auto rr = __builtin_amdgcn_permlane32_swap(__float_as_uint(l_reg), __float_as_uint(l_reg), false, false); l_reg = __uint_as_float(rr[0]) + __uint_as_float(rr[1]); }
    if (MODE == 1) l_reg += __builtin_amdgcn_exp2f(sink2 + slope2 * (float)(qrel - 255) - mhat);
    if (hi == 0) wsf[32 + r32] = l_reg; asm volatile("s_waitcnt lgkmcnt(0)" ::: "memory");
    float rli[16];
#pragma unroll
    for (int r = 0; r < 16; ++r) rli[r] = __builtin_amdgcn_rcpf(wsf[32 + crow(r, hi)]);
    bf16* Ow = O + (size_t)(q0 + wid * QBLK) * DMQ + h * D; __attribute__((address_space(3))) bf16* stg = (__attribute__((address_space(3))) bf16*)(lds + LDS_OST) + wid * 2048;
#pragma unroll
    for (int r = 0; r < 16; ++r) { const int orow = crow(r, hi);
#pragma unroll
        for (int d0 = 0; d0 < 2; ++d0) stg[orow * 64 + d0 * 32 + r32] = (bf16)f2bf(o[d0][r] * rli[r]); }
    asm volatile("s_waitcnt lgkmcnt(0)" ::: "memory");
#pragma unroll
    for (int i = 0; i < 4; ++i) { const int row = i * 8 + (lane >> 3), ch = lane & 7; *(u32x4*)(Ow + (size_t)row * DMQ + ch * 8) = *(const __attribute__((address_space(3))) u32x4*)(stg + row * 64 + ch * 8); }
    asm volatile("s_waitcnt lgkmcnt(0)\n\ts_barrier" ::: "memory");
#undef DMA_K
#undef DMA_V
#undef ROT
#undef EX
#undef RESC
#undef PKW
#undef PAF
#undef VFR
#undef VRD
#undef KRD
#undef ENDW
#undef GAPA
#undef GAPB
#undef STEP
#undef TB
#undef SELROW
}
#undef SBAR
#undef PIN
#undef MFMA
#undef WAIT_BAR
#undef MX3
}

constexpr int S = 8192, DM = 2048, HD = 64, NH = 16;
constexpr int NIN = 8704, NEXP = 32, DEXP = 512, NMOD = 12288;
constexpr float RMS_EPS = 1e-6f;
constexpr float LOG2E = 1.4426950408889634f;
constexpr float C2 = 0.125f * LOG2E;
constexpr int NWAVES = 8, NTHREADS = 512;
constexpr int PER_PHASE = 12;
constexpr int N_LAUNCHES = MK_N_LAUNCHES;

constexpr size_t MiB = 1u << 20;
constexpr size_t WS_CTL = 0, CTL_ZERO_BYTES = 1 * MiB;
constexpr size_t WS_MODP = 1 * MiB;
constexpr size_t WS_MOD = WS_MODP + 1536 * 1024;
constexpr size_t WS_KMEAN = WS_MOD + 64 * 1024;
constexpr size_t WS_WRT = WS_KMEAN + 128 * 1024;
constexpr size_t WS_SSQ = WS_WRT + 288 * 1024;
constexpr size_t WS_EW = WS_SSQ + MiB;
constexpr size_t WS_LIST = WS_EW + 64 * 1024;
constexpr size_t WS_DESC = WS_LIST + MiB;
constexpr size_t WS_SMALL_END = WS_DESC + 192 * 1024;
static_assert(WS_SMALL_END <= 6 * MiB, "small region");
constexpr size_t WS_WT_OAB = 6 * MiB;
constexpr size_t WS_WT_OUT = 14 * MiB;
constexpr size_t WS_WT_IN = 22 * MiB;
constexpr size_t WS_WT_GU = 56 * MiB;
constexpr size_t WS_WT_D = 184 * MiB;
constexpr size_t WS_XN = 248 * MiB;
constexpr size_t WS_QA = 280 * MiB, WS_KA = 296 * MiB, WS_VA = 312 * MiB, WS_QB = 328 * MiB, WS_KB = 344 * MiB, WS_VB = 348 * MiB;
constexpr size_t WS_SGA = 352 * MiB, WS_SGB = 384 * MiB;
constexpr size_t WS_Y1 = 416 * MiB;
constexpr size_t WS_Y = 448 * MiB;
constexpr size_t WS_TMPA = 512 * MiB;
constexpr size_t WS_OAB = 576 * MiB;
constexpr size_t WS_END = 608 * MiB;
constexpr size_t WS_YE = 280 * MiB;
constexpr size_t WS_ACT = 416 * MiB;
constexpr size_t WS_XG = 448 * MiB;
constexpr int MAXROWS = 24576;
static_assert(WS_XG + (size_t)MAXROWS * DM * 2 <= WS_OAB && WS_YE + (size_t)S * 2 * DM * 4 <= WS_Y1, "overlays");
constexpr int CW_TMO = 0, CW_CODE = 1, CW_BAR = 4096, CW_CNT = 8192, CW_TS = 8256, CW_KSUM = 16384;
static_assert((CW_KSUM + 16 * 32 * 64) * 4 <= (int)CTL_ZERO_BYTES, "ctl region");

constexpr int RING_OFF = 0, RING_BYTES = 131072;
constexpr int LDSCTL_OFF = RING_BYTES;
constexpr int LDS_BYTES = 147456;

typedef unsigned u32x4_t __attribute__((ext_vector_type(4)));
typedef float f32x2_t __attribute__((ext_vector_type(2)));

__device__ __forceinline__ float bf2f(unsigned short b) { return __uint_as_float(((unsigned)b) << 16); }
__device__ __forceinline__ float bflo(unsigned w) { return __uint_as_float(w << 16); }
__device__ __forceinline__ float bfhi(unsigned w) { return __uint_as_float(w & 0xffff0000u); }
__device__ __forceinline__ float wave_sum(float v) {
#pragma unroll
    for (int o = 1; o < 64; o <<= 1) v += __shfl_xor(v, o);
    return v;
}
__device__ __forceinline__ float wave_max(float v) {
#pragma unroll
    for (int o = 1; o < 64; o <<= 1) v = fmaxf(v, __shfl_xor(v, o));
    return v;
}
__device__ __forceinline__ float sigmoidf_(float v) { return __builtin_amdgcn_rcpf(1.0f + __builtin_amdgcn_exp2f(-v * LOG2E)); }

struct Ctx {
    const float* in[20]; float* out; unsigned char* ws;
    int tid, lane, wave, G, vcu;
    LAS unsigned char* lds;
};
enum { I_X = 0, I_C, I_WADA, I_BADA, I_GPRE, I_GPOST, I_WIN, I_SINKS, I_WOA, I_WOB, I_WOUT, I_GPREF, I_GPOSTF, I_WRG, I_BRG, I_WRE, I_BRE, I_WG, I_WU, I_WD };

__device__ __forceinline__ void tr_item(const float* W, int N, bf16* WT, int ldt, int wt_row0, int k0, int n0, LAS float* scr, int lane) {
#pragma unroll 8
    for (int i = 0; i < 32; ++i) { const int kk = 2 * i + (lane >> 5); scr[kk * 33 + (lane & 31)] = W[(size_t)(k0 + kk) * N + n0 + (lane & 31)]; }
    LDS_WAIT(); asm volatile("" ::: "memory");
    const int c = lane & 7;
#pragma unroll
    for (int j = 0; j < 4; ++j) { const int n = (lane >> 3) + 8 * j; const LAS float* s = scr + (8 * c) * 33 + n;
        v4u o; o.x = pk2(s[0 * 33], s[1 * 33]); o.y = pk2(s[2 * 33], s[3 * 33]); o.z = pk2(s[4 * 33], s[5 * 33]); o.w = pk2(s[6 * 33], s[7 * 33]);
        *(GAS v4u*)(WT + (size_t)(wt_row0 + n) * ldt + k0 + 8 * c) = o; }
    LDS_WAIT(); asm volatile("" ::: "memory");
}
__device__ __forceinline__ void phase0(Ctx& F) {
    LAS float* scr = (LAS float*)(F.lds + RING_OFF + F.wave * 16384);
    const int gw = F.vcu * NWAVES + F.wave, NGW = F.G * NWAVES, lane = F.lane;
    constexpr int I_GEMV = 32 * 48, I_RT = 36;
    constexpr int I_IN = 32 * 272, I_OA = 16 * 64, I_OUT = 32 * 64, I_E = 32 * 512;
    constexpr int NITEMS = I_GEMV + I_RT + I_IN + 2 * I_OA + I_OUT + 3 * I_E;
    bf16* WT_OAB = (bf16*)(F.ws + WS_WT_OAB); bf16* WT_OUT = (bf16*)(F.ws + WS_WT_OUT); bf16* WT_IN = (bf16*)(F.ws + WS_WT_IN);
    bf16* WT_GU = (bf16*)(F.ws + WS_WT_GU); bf16* WT_D = (bf16*)(F.ws + WS_WT_D);
    for (int it = gw; it < NITEMS; it += NGW) {
        int r = it;
        if (r < I_GEMV) {
            const int kc = r / 48, span = r % 48;
            const float cv = F.in[I_C][64 * kc + lane];
            const float sv = cv / (1.0f + expf(-cv));
            f32x4 acc = {0.f, 0.f, 0.f, 0.f};
            const float* wp = F.in[I_WADA] + (size_t)(64 * kc) * NMOD + 256 * span + 4 * lane;
#pragma unroll 8
            for (int rr = 0; rr < 64; ++rr) { const f32x4 w = *(const GAS f32x4*)(wp + (size_t)rr * NMOD); const float s = __shfl(sv, rr); acc += w * s; }
            *(GAS f32x4*)((float*)(F.ws + WS_MODP) + (size_t)kc * NMOD + 256 * span + 4 * lane) = acc;
            continue;
        }
        r -= I_GEMV;
        if (r < I_RT) {
            float* wrt = (float*)(F.ws + WS_WRT) + (size_t)r * DM;
            for (int d = lane; d < DM; d += 64) wrt[d] = (r < 4) ? F.in[I_WRG][d * 4 + r] : F.in[I_WRE][d * 32 + (r - 4)];
            continue;
        }
        r -= I_RT;
        if (r < I_IN) { const int kb = r / 272, nb = r % 272; tr_item(F.in[I_WIN], NIN, WT_IN, DM, 32 * nb, 64 * kb, 32 * nb, scr, lane); continue; }
        r -= I_IN;
        if (r < I_OA) { const int kb = r / 64, nb = r % 64; tr_item(F.in[I_WOA], DM, WT_OAB, 1024, 32 * nb, 64 * kb, 32 * nb, scr, lane); continue; }
        r -= I_OA;
        if (r < I_OA) { const int kb = r / 64, nb = r % 64; tr_item(F.in[I_WOB], DM, WT_OAB + (size_t)DM * 1024, 1024, 32 * nb, 64 * kb, 32 * nb, scr, lane); continue; }
        r -= I_OA;
        if (r < I_OUT) { const int kb = r / 64, nb = r % 64; tr_item(F.in[I_WOUT], DM, WT_OUT, DM, 32 * nb, 64 * kb, 32 * nb, scr, lane); continue; }
        r -= I_OUT;
        if (r < I_E) { const int e = r / 512, rr = r % 512, kb = rr / 16, nb = rr % 16, n0 = 32 * nb;
            tr_item(F.in[I_WG] + (size_t)e * DM * DEXP, DEXP, WT_GU, DM, e * 1024 + 256 * (n0 >> 7) + (n0 & 127), 64 * kb, n0, scr, lane); continue; }
        r -= I_E;
        if (r < I_E) { const int e = r / 512, rr = r % 512, kb = rr / 16, nb = rr % 16, n0 = 32 * nb;
            tr_item(F.in[I_WU] + (size_t)e * DM * DEXP, DEXP, WT_GU, DM, e * 1024 + 256 * (n0 >> 7) + 128 + (n0 & 127), 64 * kb, n0, scr, lane); continue; }
        r -= I_E;
        { const int e = r / 512, rr = r % 512, kb = rr / 64, nb = rr % 64;
            tr_item(F.in[I_WD] + (size_t)e * DEXP * DM, DM, WT_D, DEXP, e * 2048 + 32 * nb, 64 * kb, 32 * nb, scr, lane); }
    }
}

__device__ __forceinline__ float mod_value(const Ctx& F, int n) {
    const float* mp = (const float*)(F.ws + WS_MODP) + n;
    float s = F.in[I_BADA][n];
#pragma unroll 8
    for (int kc = 0; kc < 32; ++kc) s += mp[(size_t)kc * NMOD];
    return s;
}
__device__ __forceinline__ void phase1(Ctx& F) {
    LAS float* gs = (LAS float*)(F.lds + RING_OFF);
    LAS float* sh = gs + DM;
    for (int n = F.tid; n < DM; n += NTHREADS) { const float shv = mod_value(F, n), scv = mod_value(F, DM + n); gs[n] = F.in[I_GPRE][n] * (1.0f + scv); sh[n] = shv; }
    { const int per = NMOD / F.G + 1; const int n = blockIdx.x * per + F.tid; if (F.tid < per && n < NMOD) ((float*)(F.ws + WS_MOD))[n] = mod_value(F, n); }
    __syncthreads();
    const int gw = F.vcu * NWAVES + F.wave, NGW = F.G * NWAVES, lane = F.lane;
    bf16* XN = (bf16*)(F.ws + WS_XN);
    for (int m = gw; m < S; m += NGW) {
        const GAS f32x4* xr = (const GAS f32x4*)(F.in[I_X] + (size_t)m * DM) + lane;
        f32x4 v[8]; float s2 = 0.f;
#pragma unroll
        for (int j = 0; j < 8; ++j) { v[j] = xr[64 * j]; s2 += (v[j].x * v[j].x + v[j].y * v[j].y) + (v[j].z * v[j].z + v[j].w * v[j].w); }
        const float rstd = 1.0f / sqrtf(wave_sum(s2) * (1.0f / DM) + RMS_EPS);
        GAS unsigned long long* o8 = (GAS unsigned long long*)(XN + (size_t)m * DM) + lane;
#pragma unroll
        for (int j = 0; j < 8; ++j) { const int d = 4 * lane + 256 * j; const f32x4 g4 = *(const LAS f32x4*)(gs + d), s4 = *(const LAS f32x4*)(sh + d);
            const f32x4 h = v[j] * rstd * g4 + s4;
            o8[64 * j] = (unsigned long long)pk2(h.x, h.y) | ((unsigned long long)pk2(h.z, h.w) << 32); }
    }
    __syncthreads();
}

template <class Epi, class Sched>
__device__ __forceinline__ void gemm_naive(const pg8::Gemm g, const Sched& Sc, const Epi& E) {
    using namespace pg8;
    const int tid = threadIdx.x, wid = __builtin_amdgcn_readfirstlane(tid >> 6), lane = tid & 63, wr = wid >> 2, wc = wid & 3, fr = lane & 15, fq = lane >> 4;
    const int K = g.K;
    Unit u;
    for (int i = 0; Sc.next(i, u); ++i) {
        pg8::f32x4 acc[2][2][4][2];
#pragma unroll
        for (int a = 0; a < 2; ++a)
#pragma unroll
            for (int b = 0; b < 2; ++b)
#pragma unroll
                for (int m = 0; m < 4; ++m)
#pragma unroll
                    for (int n = 0; n < 2; ++n) acc[a][b][m][n] = (pg8::f32x4){0.f, 0.f, 0.f, 0.f};
        const bf16_t* Ab = g.A + (size_t)u.pm * 256 * K; const bf16_t* Bb = g.Bt + (size_t)u.pn * 256 * K;
        const bf16_t* Ap = Ab + (size_t)(64 * wr + fr) * K + 8 * fq;
        const bf16_t* Bp = Bb + (size_t)(32 * wc) * K + 8 * fq;
        const int c0 = Epi::PERM ? perm32(fr) : fr, c1 = Epi::PERM ? perm32(16 + fr) : 16 + fr;
#pragma unroll 1
        for (int k0 = 0; k0 < K; k0 += 32) {
            pg8::bf16x8 b[2][2];
#pragma unroll
            for (int bj = 0; bj < 2; ++bj) { b[bj][0] = *(const pg8::bf16x8*)(Bp + (size_t)(128 * bj + c0) * K + k0); b[bj][1] = *(const pg8::bf16x8*)(Bp + (size_t)(128 * bj + c1) * K + k0); }
#pragma unroll
            for (int ai = 0; ai < 2; ++ai) {
                pg8::bf16x8 a[4];
#pragma unroll
                for (int m = 0; m < 4; ++m) a[m] = *(const pg8::bf16x8*)(Ap + (size_t)(128 * ai + 16 * m) * K + k0);
#pragma unroll
                for (int bj = 0; bj < 2; ++bj)
#pragma unroll
                    for (int m = 0; m < 4; ++m)
#pragma unroll
                        for (int n = 0; n < 2; ++n) acc[ai][bj][m][n] = __builtin_amdgcn_mfma_f32_16x16x32_bf16(b[bj][n], a[m], acc[ai][bj][m][n], 0, 0, 0);
                asm volatile("" ::: "memory");
            }
        }
        E(acc, u, wr, wc, fr, fq);
    }
}
template <class Epi, class Sched>
__device__ __forceinline__ void run_gemm(Ctx& F, const pg8::Gemm g, const Sched& Sc, const Epi& E) {
#if FAST_GEMM
    pg8::gemm_phase<Epi, Sched, true, true>((PG8_LAS unsigned char*)(F.lds + RING_OFF), g, Sc, E);
#else
    static_assert(!Sched::GATHER, "the reference GEMM has no gathered form"); gemm_naive<Epi, Sched>(g, Sc, E);
#endif
}

typedef pg8::f32x4 acc_t[2][2][4][2];
struct EpiQKVG {
    static constexpr bool PERM = true, AFTER_DRAIN = false;
    unsigned char* ws;
    __device__ __forceinline__ void operator()(const acc_t& acc, const pg8::Unit& u, int wr, int wc, int fr, int fq) const {
        const int pn = u.pn; bf16* base; int ldc, colt; float sc = 1.0f; bool sig = false;
        if (pn < 4) { base = (bf16*)(ws + WS_QA); ldc = 1024; colt = 256 * pn; sc = C2; }
        else if (pn < 8) { base = (bf16*)(ws + WS_KA); ldc = 1024; colt = 256 * (pn - 4); }
        else if (pn < 12) { base = (bf16*)(ws + WS_VA); ldc = 1024; colt = 256 * (pn - 8); }
        else if (pn < 16) { base = (bf16*)(ws + WS_QB); ldc = 1024; colt = 256 * (pn - 12); sc = C2; }
        else if (pn == 16) { base = (bf16*)(ws + WS_KB); ldc = 256; colt = 0; }
        else if (pn == 17) { base = (bf16*)(ws + WS_VB); ldc = 256; colt = 0; }
        else if (pn < 26) { base = (bf16*)(ws + WS_SGA); ldc = 2048; colt = 256 * (pn - 18); sig = true; }
        else { base = (bf16*)(ws + WS_SGB); ldc = 2048; colt = 256 * (pn - 26); sig = true; }
        const int row0 = u.pm * 256 + wr * 64 + fr, col0 = colt + wc * 32 + 8 * fq;
#pragma unroll
        for (int ai = 0; ai < 2; ++ai)
#pragma unroll
            for (int m = 0; m < 4; ++m) { bf16* rowp = base + (size_t)(row0 + ai * 128 + m * 16) * ldc + col0;
#pragma unroll
                for (int bj = 0; bj < 2; ++bj) { pg8::f32x4 v0 = acc[ai][bj][m][0], v1 = acc[ai][bj][m][1];
                    if (sig) { v0 = (pg8::f32x4){sigmoidf_(v0[0]), sigmoidf_(v0[1]), sigmoidf_(v0[2]), sigmoidf_(v0[3])}; v1 = (pg8::f32x4){sigmoidf_(v1[0]), sigmoidf_(v1[1]), sigmoidf_(v1[2]), sigmoidf_(v1[3])}; }
                    else { v0 = v0 * sc; v1 = v1 * sc; }
                    pg8::u32x4 w; w.x = pg8::cvt_pk_bf16(v0[0], v0[1]); w.y = pg8::cvt_pk_bf16(v0[2], v0[3]); w.z = pg8::cvt_pk_bf16(v1[0], v1[1]); w.w = pg8::cvt_pk_bf16(v1[2], v1[3]);
                    *(pg8::u32x4*)(rowp + bj * 128) = w; } }
        if (pn >= 4 && pn < 8) {
            float* ks = (float*)(ws + WS_CTL) + CW_KSUM;
#pragma unroll
            for (int bj = 0; bj < 2; ++bj)
#pragma unroll
                for (int n = 0; n < 2; ++n) { pg8::f32x4 cs = {0.f, 0.f, 0.f, 0.f};
#pragma unroll
                    for (int ai = 0; ai < 2; ++ai)
#pragma unroll
                        for (int m = 0; m < 4; ++m) cs += acc[ai][bj][m][n];
#pragma unroll
                    for (int o = 1; o < 16; o <<= 1) { cs[0] += __shfl_xor(cs[0], o); cs[1] += __shfl_xor(cs[1], o); cs[2] += __shfl_xor(cs[2], o); cs[3] += __shfl_xor(cs[3], o); }
                    if (fr == 0) { const int col = 256 * (pn - 4) + 128 * bj + 32 * wc + 8 * fq + 4 * n;
                        float* dst = ks + ((size_t)(col >> 6) * 32 + u.pm) * 64 + (col & 63);
                        atomicAdd(dst + 0, cs[0]); atomicAdd(dst + 1, cs[1]); atomicAdd(dst + 2, cs[2]); atomicAdd(dst + 3, cs[3]); } }
        }
    }
};
struct EpiGate {
    static constexpr bool PERM = true, AFTER_DRAIN = false;
    unsigned char* ws;
    __device__ __forceinline__ void operator()(const acc_t& acc, const pg8::Unit& u, int wr, int wc, int fr, int fq) const {
        const int which = u.pm >> 5, pm = u.pm & 31, pn = u.pn & 7;
        const bf16* SG = (const bf16*)(ws + (which ? WS_SGB : WS_SGA)); float* T = (float*)(ws + WS_TMPA); bf16* Y1 = (bf16*)(ws + WS_Y1);
        const int row0 = pm * 256 + wr * 64 + fr, col0 = pn * 256 + wc * 32 + 8 * fq;
#pragma unroll
        for (int ai = 0; ai < 2; ++ai)
#pragma unroll
            for (int m = 0; m < 4; ++m)
#pragma unroll
                for (int bj = 0; bj < 2; ++bj) { const size_t off = (size_t)(row0 + ai * 128 + m * 16) * DM + col0 + bj * 128;
                    const pg8::u32x4 sg = *(const pg8::u32x4*)(SG + off);
                    pg8::f32x4 v0 = acc[ai][bj][m][0], v1 = acc[ai][bj][m][1];
                    v0[0] *= bflo(sg.x); v0[1] *= bfhi(sg.x); v0[2] *= bflo(sg.y); v0[3] *= bfhi(sg.y);
                    v1[0] *= bflo(sg.z); v1[1] *= bfhi(sg.z); v1[2] *= bflo(sg.w); v1[3] *= bfhi(sg.w);
                    if (which == 0) { *(pg8::f32x4*)(T + off) = v0; *(pg8::f32x4*)(T + off + 4) = v1; }
                    else { const pg8::f32x4 t0 = *(const pg8::f32x4*)(T + off), t1 = *(const pg8::f32x4*)(T + off + 4); v0 += t0; v1 += t1;
                        pg8::u32x4 w; w.x = pg8::cvt_pk_bf16(v0[0], v0[1]); w.y = pg8::cvt_pk_bf16(v0[2], v0[3]); w.z = pg8::cvt_pk_bf16(v1[0], v1[1]); w.w = pg8::cvt_pk_bf16(v1[2], v1[3]);
                        *(pg8::u32x4*)(Y1 + off) = w; } }
    }
};
struct EpiY {
    static constexpr bool PERM = false, AFTER_DRAIN = false;
    unsigned char* ws;
    __device__ __forceinline__ void operator()(const acc_t& acc, const pg8::Unit& u, int wr, int wc, int fr, int fq) const {
        float* Y = (float*)(ws + WS_Y); float* SSQ = (float*)(ws + WS_SSQ);
        const int row0 = u.pm * 256 + wr * 64 + fr, col0 = u.pn * 256 + wc * 32 + 4 * fq;
#pragma unroll
        for (int ai = 0; ai < 2; ++ai)
#pragma unroll
            for (int m = 0; m < 4; ++m) { const int row = row0 + ai * 128 + m * 16; float ss = 0.f;
#pragma unroll
                for (int bj = 0; bj < 2; ++bj)
#pragma unroll
                    for (int n = 0; n < 2; ++n) { const pg8::f32x4 v = acc[ai][bj][m][n]; *(pg8::f32x4*)(Y + (size_t)row * DM + col0 + bj * 128 + n * 16) = v;
                        ss += (v[0] * v[0] + v[1] * v[1]) + (v[2] * v[2] + v[3] * v[3]); }
                ss += __shfl_xor(ss, 16); ss += __shfl_xor(ss, 32);
                if (fq == 0) SSQ[(size_t)row * 32 + u.pn * 4 + wc] = ss; }
    }
};
struct EpiGU {
    static constexpr bool PERM = true, AFTER_DRAIN = false;
    unsigned char* ws;
    __device__ __forceinline__ void operator()(const acc_t& acc, const pg8::Unit& u, int wr, int wc, int fr, int fq) const {
        bf16* ACT = (bf16*)(ws + WS_ACT);
        const int row0 = u.pm * 256 + wr * 64 + fr, col0 = (u.pn & 3) * 128 + wc * 32 + 8 * fq;
#pragma unroll
        for (int ai = 0; ai < 2; ++ai)
#pragma unroll
            for (int m = 0; m < 4; ++m) { float a[8];
#pragma unroll
                for (int n = 0; n < 2; ++n)
#pragma unroll
                    for (int i = 0; i < 4; ++i) { const float gv = acc[ai][0][m][n][i], uv = acc[ai][1][m][n][i]; a[4 * n + i] = gv * sigmoidf_(gv) * uv; }
                pg8::u32x4 w; w.x = pg8::cvt_pk_bf16(a[0], a[1]); w.y = pg8::cvt_pk_bf16(a[2], a[3]); w.z = pg8::cvt_pk_bf16(a[4], a[5]); w.w = pg8::cvt_pk_bf16(a[6], a[7]);
                *(pg8::u32x4*)(ACT + (size_t)(row0 + ai * 128 + m * 16) * DEXP + col0) = w; }
    }
};
struct EpiDown {
    static constexpr bool PERM = false, AFTER_DRAIN = false;
    unsigned char* ws; const volatile LAS int* mts;
    __device__ __forceinline__ void operator()(const acc_t& acc, const pg8::Unit& u, int wr, int wc, int fr, int fq) const {
        float* YE = (float*)(ws + WS_YE); const int* LIST = (const int*)(ws + WS_LIST); const float* EW = (const float*)(ws + WS_EW);
        const int e = u.pn >> 3, cnt = mts[33 + e], pos0 = 256 * (u.pm - mts[e]) + wr * 64 + fr, col0 = (u.pn & 7) * 256 + wc * 32 + 4 * fq;
#pragma unroll
        for (int ai = 0; ai < 2; ++ai)
#pragma unroll
            for (int m = 0; m < 4; ++m) { const int pos = pos0 + ai * 128 + m * 16;
                if (pos < cnt) { const int ent = LIST[e * S + pos]; const float w = EW[ent];
#pragma unroll
                    for (int bj = 0; bj < 2; ++bj)
#pragma unroll
                        for (int n = 0; n < 2; ++n) *(pg8::f32x4*)(YE + (size_t)ent * DM + col0 + bj * 128 + n * 16) = acc[ai][bj][m][n] * w; } }
    }
};

struct GateOrder {
    static constexpr bool GATHER = false;
    pg8::StaticOrder so;
    __device__ void init(int G, int c) { so.init(S, DM, G, c); }
    __device__ bool next(int i, pg8::Unit& u) const {
        const int rounds = (so.nwg + so.G - 1) / so.G;
        const int which = i & 1, ti = i >> 1; if (ti >= rounds) return false;
        pg8::Unit t; if (!so.next(ti, t)) return false;
        u.pm = t.pm + 32 * which; u.pn = t.pn + 8 * which; return true;
    }
    __device__ __forceinline__ void a_ready(const pg8::Unit&) const {}
    __device__ __forceinline__ void done(const pg8::Unit&) const {}
};
template <bool GATHER_>
struct MoeOrder {
    static constexpr bool GATHER = GATHER_;
    const volatile LAS int* mts; int shift, G, v; const int* list;
    __device__ bool next(int i, pg8::Unit& u) const {
        const int total = mts[32] << shift; const int L = i * G + v; if (L >= total) return false;
        const int mt = L >> shift, pn = L & ((1 << shift) - 1); int e = 0;
        for (int j = 1; j < 32; ++j) e += (mts[j] <= mt) ? 1 : 0;
        u.pm = mt; u.pn = (e << shift) | pn; return true;
    }
    __device__ __forceinline__ int arow(const pg8::Unit& u, int r) const {
        const int e = u.pn >> shift, pos = 256 * (u.pm - mts[e]) + r;
        return pos < mts[33 + e] ? (list[e * S + pos] >> 1) : 0;
    }
    __device__ __forceinline__ void a_ready(const pg8::Unit&) const {}
    __device__ __forceinline__ void done(const pg8::Unit&) const {}
};
__device__ __forceinline__ void build_mts(Ctx& F) {
    volatile LAS int* mts = (volatile LAS int*)(F.lds + LDSCTL_OFF) + 64;
    __syncthreads();
    if (F.tid == 0) { const gu32* cnt = (const gu32*)(F.ws + WS_CTL) + CW_CNT; int acc = 0;
        for (int e = 0; e < 32; ++e) { mts[e] = acc; const int c = (int)__hip_atomic_load(cnt + e, RLX_AGENT); mts[33 + e] = c; acc += (c + 255) >> 8; }
        mts[32] = acc; }
    __syncthreads();
}

__device__ __forceinline__ void phase3(Ctx& F) {
    const int gw = F.vcu * NWAVES + F.wave, NGW = F.G * NWAVES, lane = F.lane;
    const bf16* KA = (const bf16*)(F.ws + WS_KA); float* KM = (float*)(F.ws + WS_KMEAN);
    for (int it = gw; it < 16 * 32; it += NGW) { const int h = it >> 5, j = it & 31; float s = 0.f;
        const bf16* p = KA + (size_t)(256 * j) * 1024 + 64 * h + lane;
#pragma unroll 8
        for (int r = 0; r < 256; ++r) s += bf2f(p[(size_t)r * 1024]);
        KM[(size_t)it * 64 + lane] = s * (1.0f / 256.0f); }
}

__device__ __forceinline__ void attn_naive(Ctx& F, int it_lo, int it_hi) {
    const int gw = F.vcu * NWAVES + F.wave, NGW = F.G * NWAVES, lane = F.lane;
    LAS float* wscr = (LAS float*)(F.lds + RING_OFF) + F.wave * 1280;
    LAS float* qs = wscr + 1024; LAS float* gsb = wscr + 1088;
    const bf16* QA = (const bf16*)(F.ws + WS_QA); const bf16* KA = (const bf16*)(F.ws + WS_KA); const bf16* VA = (const bf16*)(F.ws + WS_VA);
    const bf16* QB = (const bf16*)(F.ws + WS_QB); const bf16* KB = (const bf16*)(F.ws + WS_KB); const bf16* VB = (const bf16*)(F.ws + WS_VB);
    const float* KM = (const float*)(F.ws + WS_CTL) + CW_KSUM;
    bf16* OA = (bf16*)(F.ws + WS_OAB); bf16* OB = OA + (size_t)S * 1024;
    const float NEG = -INFINITY;
    for (int it = it_lo + gw; it < it_hi; it += NGW) {
        const int mode = it / (S * NH), rem = it % (S * NH), t = rem >> 4, h = rem & 15;
        const float slope2 = exp2f(-0.5f * (float)(h + 1)) * LOG2E;
        if (mode == 0) {
            const int blk = t >> 8;
            qs[lane] = bf2f(QA[(size_t)t * 1024 + 64 * h + lane]);
            LDS_WAIT(); asm volatile("" ::: "memory");
            float g = NEG;
            if (lane < blk) { g = 0.f; const float* kmp = KM + (size_t)(h * 32 + lane) * 64; for (int d = 0; d < 64; ++d) g += qs[d] * kmp[d]; }
            if (lane < 32) gsb[lane] = g;
            LDS_WAIT(); asm volatile("" ::: "memory");
            float b0 = NEG, b1 = NEG, b2 = NEG; int i0 = -1, i1 = -1, i2 = -1;
            for (int j = 0; j < blk; ++j) { const float v = gsb[j];
                if (v > b0) { b2 = b1; i2 = i1; b1 = b0; i1 = i0; b0 = v; i0 = j; }
                else if (v > b1) { b2 = b1; i2 = i1; b1 = v; i1 = j; }
                else if (v > b2) { b2 = v; i2 = j; } }
            float mx = NEG; int nk = 0;
            for (int seg = 0; seg < 4; ++seg) { const int bj = seg == 0 ? i0 : seg == 1 ? i1 : seg == 2 ? i2 : blk; if (bj < 0) continue;
                const int nkeys = (seg == 3) ? (t & 255) + 1 : 256;
                for (int k0 = 0; k0 < nkeys; k0 += 64) { const int key = k0 + lane;
                    if (key < nkeys) { const int kp = bj * 256 + key; const GAS v4u* kr = (const GAS v4u*)(KA + (size_t)kp * 1024 + 64 * h); float s = 0.f;
#pragma unroll
                        for (int d8 = 0; d8 < 8; ++d8) { const v4u kv = kr[d8]; const LAS float* q8 = qs + 8 * d8;
                            s += q8[0] * bflo(kv.x) + q8[1] * bfhi(kv.x) + q8[2] * bflo(kv.y) + q8[3] * bfhi(kv.y) + q8[4] * bflo(kv.z) + q8[5] * bfhi(kv.z) + q8[6] * bflo(kv.w) + q8[7] * bfhi(kv.w); }
                        s += slope2 * (float)(kp - t); wscr[nk + key] = s; mx = fmaxf(mx, s); } }
                nk += nkeys; }
            mx = wave_max(mx);
            LDS_WAIT(); asm volatile("" ::: "memory");
            float l = 0.f, o = 0.f; int idx = 0;
            for (int seg = 0; seg < 4; ++seg) { const int bj = seg == 0 ? i0 : seg == 1 ? i1 : seg == 2 ? i2 : blk; if (bj < 0) continue;
                const int nkeys = (seg == 3) ? (t & 255) + 1 : 256;
                const bf16* vr = VA + (size_t)(bj * 256) * 1024 + 64 * h + lane;
                for (int key = 0; key < nkeys; ++key) { const float p = exp2f(wscr[idx + key] - mx); l += p; o += p * bf2f(vr[(size_t)key * 1024]); }
                idx += nkeys; }
            OA[(size_t)t * 1024 + 64 * h + lane] = (bf16)f2bf(o / l);
            LDS_WAIT(); asm volatile("" ::: "memory");
        } else {
            const int hkv = h >> 2; const float sink2 = F.in[I_SINKS][h] * LOG2E;
            qs[lane] = bf2f(QB[(size_t)t * 1024 + 64 * h + lane]);
            LDS_WAIT(); asm volatile("" ::: "memory");
            const int kp0 = t - 127 > 0 ? t - 127 : 0, nkeys = t - kp0 + 1;
            float mx = NEG;
            for (int k0 = 0; k0 < nkeys; k0 += 64) { const int key = k0 + lane;
                if (key < nkeys) { const int kp = kp0 + key; const GAS v4u* kr = (const GAS v4u*)(KB + (size_t)kp * 256 + 64 * hkv); float s = 0.f;
#pragma unroll
                    for (int d8 = 0; d8 < 8; ++d8) { const v4u kv = kr[d8]; const LAS float* q8 = qs + 8 * d8;
                        s += q8[0] * bflo(kv.x) + q8[1] * bfhi(kv.x) + q8[2] * bflo(kv.y) + q8[3] * bfhi(kv.y) + q8[4] * bflo(kv.z) + q8[5] * bfhi(kv.z) + q8[6] * bflo(kv.w) + q8[7] * bfhi(kv.w); }
                    s += slope2 * (float)(kp - t); wscr[key] = s; mx = fmaxf(mx, s); } }
            mx = wave_max(mx);
            LDS_WAIT(); asm volatile("" ::: "memory");
            float l = exp2f(sink2 - mx), o = 0.f;
            const bf16* vr = VB + (size_t)kp0 * 256 + 64 * hkv + lane;
            for (int key = 0; key < nkeys; ++key) { const float p = exp2f(wscr[key] - mx); l += p; o += p * bf2f(vr[(size_t)key * 256]); }
            OB[(size_t)t * 1024 + 64 * h + lane] = (bf16)f2bf(o / l);
            LDS_WAIT(); asm volatile("" ::: "memory");
        }
    }
}

__device__ __forceinline__ void attn_fast(Ctx& F, bool do_moba, bool do_swa, size_t out_ws = WS_OAB) {
    att::lds_ptr L = (att::lds_ptr)(F.lds + RING_OFF);
    const bf16* QA = (const bf16*)(F.ws + WS_QA); const bf16* KA = (const bf16*)(F.ws + WS_KA); const bf16* VA = (const bf16*)(F.ws + WS_VA);
    const bf16* QB = (const bf16*)(F.ws + WS_QB); const bf16* KB = (const bf16*)(F.ws + WS_KB); const bf16* VB = (const bf16*)(F.ws + WS_VB);
    const float* KM = (const float*)(F.ws + WS_CTL) + CW_KSUM;
    bf16* OA = (bf16*)(F.ws + out_ws); bf16* OB = OA + (size_t)S * 1024;
    if (do_moba) for (int p = F.vcu; p < 256; p += F.G) {
        const int h = p >> 4, s = p & 15; const float slope2 = exp2f(-0.5f * (float)(h + 1)) * LOG2E;
        for (int k = 0; k < 2; ++k) att::unit<0>(h, k ? s : 31 - s, QA, KA, VA, OA, KM + (size_t)h * 32 * 64, slope2, 0.f, L);
    }
    if (do_swa) for (int p = F.vcu; p < 256; p += F.G) {
        for (int k = 0; k < 2; ++k) { const int u = 2 * p + k, h = u >> 5, qb = u & 31; const float slope2 = exp2f(-0.5f * (float)(h + 1)) * LOG2E;
            att::unit<1>(h, qb, QB, KB, VB, OB, nullptr, slope2, F.in[I_SINKS][h] * LOG2E, L); }
    }
}


#if defined(ATT_DIAG)
constexpr int CW_DIAG = 8320;
__device__ __forceinline__ void attn_diag_compare(Ctx& F) {
    const unsigned short* N0 = (const unsigned short*)(F.ws + WS_OAB); const unsigned short* F1 = (const unsigned short*)(F.ws + WS_Y); const unsigned short* F2 = (const unsigned short*)(F.ws + WS_TMPA);
    gu32* dg = (gu32*)(F.ws + WS_CTL) + CW_DIAG;
    const size_t n = (size_t)2 * S * 1024; unsigned ca = 0, cb = 0; float mx = 0.f;
    const size_t lo = (size_t)ATT_DIAG_LO * S * 1024, hi_ = (size_t)ATT_DIAG_HI * S * 1024;
    for (size_t i = lo + (size_t)blockIdx.x * NTHREADS + F.tid; i < hi_; i += (size_t)F.G * NTHREADS) {
        const unsigned short a = F1[i], b = F2[i]; if (a != b) ++ca;
        const float d = fabsf(bf2f(a) - bf2f(N0[i])); if (d > 0.02f + 0.02f * fabsf(bf2f(N0[i]))) { ++cb; __hip_atomic_fetch_add(dg + 16 + (int)((i >> 10) & 255), 1u, RLX_AGENT); __hip_atomic_fetch_add(dg + 16 + 256 + (int)((i >> 6) & 15), 1u, RLX_AGENT); } mx = fmaxf(mx, d); }
    (void)n;
    if (ca) __hip_atomic_fetch_add(dg + 0, ca, RLX_AGENT); if (cb) __hip_atomic_fetch_add(dg + 1, cb, RLX_AGENT);
    __hip_atomic_fetch_max(dg + 2, __float_as_uint(mx), RLX_AGENT);
}
#endif
__device__ __forceinline__ void phase7(Ctx& F, bool do_lists = true) {
    LAS float* gm = (LAS float*)(F.lds + RING_OFF);
    LAS float* gsf = gm + DM;
    LAS float* shf = gsf + DM;
    const float* MOD = (const float*)(F.ws + WS_MOD);
    for (int n = F.tid; n < DM; n += NTHREADS) { gm[n] = MOD[2 * DM + n] * F.in[I_GPOST][n]; gsf[n] = F.in[I_GPREF][n] * (1.0f + MOD[4 * DM + n]); shf[n] = MOD[3 * DM + n]; }
    __syncthreads();
    const int gw = F.vcu * NWAVES + F.wave, NGW = F.G * NWAVES, lane = F.lane;
    const float* Y = (const float*)(F.ws + WS_Y); const float* SSQ = (const float*)(F.ws + WS_SSQ); const float* WRT = (const float*)(F.ws + WS_WRT);
    bf16* XN = (bf16*)(F.ws + WS_XN); float* EW = (float*)(F.ws + WS_EW); int* LIST = (int*)(F.ws + WS_LIST);
    gu32* CNT = (gu32*)(F.ws + WS_CTL) + CW_CNT;
    constexpr int R = 2;
    for (int m0 = gw * R; m0 < S; m0 += NGW * R) {
        f32x4 h[R][8];
#pragma unroll
        for (int r = 0; r < R; ++r) { const int m = m0 + r;
            const float ssq = wave_sum(lane < 32 ? SSQ[(size_t)m * 32 + lane] : 0.f);
            const float rstdy = 1.0f / sqrtf(ssq * (1.0f / DM) + RMS_EPS);
            const GAS f32x4* yr = (const GAS f32x4*)(Y + (size_t)m * DM) + lane; const GAS f32x4* xr = (const GAS f32x4*)(F.in[I_X] + (size_t)m * DM) + lane;
            GAS f32x4* xo = (GAS f32x4*)(F.out + (size_t)m * DM) + lane; float s2 = 0.f;
#pragma unroll
            for (int j = 0; j < 8; ++j) { const int d = 4 * lane + 256 * j; const f32x4 g4 = *(const LAS f32x4*)(gm + d);
                const f32x4 xm = xr[64 * j] + g4 * (yr[64 * j] * rstdy); xo[64 * j] = xm; h[r][j] = xm;
                s2 += (xm.x * xm.x + xm.y * xm.y) + (xm.z * xm.z + xm.w * xm.w); }
            const float rstd2 = 1.0f / sqrtf(wave_sum(s2) * (1.0f / DM) + RMS_EPS);
            GAS unsigned long long* o8 = (GAS unsigned long long*)(XN + (size_t)m * DM) + lane;
#pragma unroll
            for (int j = 0; j < 8; ++j) { const int d = 4 * lane + 256 * j; const f32x4 g4 = *(const LAS f32x4*)(gsf + d), s4 = *(const LAS f32x4*)(shf + d);
                const f32x4 hv = h[r][j] * rstd2 * g4 + s4; h[r][j] = hv;
                o8[64 * j] = (unsigned long long)pk2(hv.x, hv.y) | ((unsigned long long)pk2(hv.z, hv.w) << 32); }
            asm volatile("" ::: "memory");
        }
        float lg[R];
#pragma unroll
        for (int r = 0; r < R; ++r) lg[r] = 0.f;
#pragma unroll 1
        for (int o = 0; o < 36; ++o) {
            const GAS f32x4* wr_ = (const GAS f32x4*)(WRT + (size_t)o * DM) + lane;
            float p[R];
#pragma unroll
            for (int r = 0; r < R; ++r) p[r] = 0.f;
#pragma unroll
            for (int j = 0; j < 8; ++j) { const f32x4 w = wr_[64 * j];
#pragma unroll
                for (int r = 0; r < R; ++r) p[r] += (h[r][j].x * w.x + h[r][j].y * w.y) + (h[r][j].z * w.z + h[r][j].w * w.w); }
            const float bias = (o < 4) ? F.in[I_BRG][o] : F.in[I_BRE][o - 4];
#pragma unroll
            for (int r = 0; r < R; ++r) { const float t = wave_sum(p[r]) + bias; lg[r] = (lane == o) ? t : lg[r]; }
        }
#pragma unroll
        for (int r = 0; r < R; ++r) { const int m = m0 + r;
            const float g0 = __shfl(lg[r], 0), g1 = __shfl(lg[r], 1), g2 = __shfl(lg[r], 2), g3 = __shfl(lg[r], 3);
            int gsel = 0; float gmax = g0;
            if (g1 > gmax) { gmax = g1; gsel = 1; } if (g2 > gmax) { gmax = g2; gsel = 2; } if (g3 > gmax) { gmax = g3; gsel = 3; }
            const float gw_ = 1.0f / (expf(g0 - gmax) + expf(g1 - gmax) + expf(g2 - gmax) + expf(g3 - gmax));
            float t0 = -INFINITY, t1 = -INFINITY; int j0 = 0, j1 = 0;
#pragma unroll
            for (int i = 0; i < 8; ++i) { const float v = __shfl(lg[r], 4 + 8 * gsel + i);
                if (v > t0) { t1 = t0; j1 = j0; t0 = v; j0 = i; } else if (v > t1) { t1 = v; j1 = i; } }
            const float e1 = expf(t1 - t0), w0 = gw_ / (1.0f + e1), w1 = gw_ * e1 / (1.0f + e1);
            if (lane == 0 && do_lists) {
                const int ea = gsel * 8 + j0, eb = gsel * 8 + j1;
                const int pa = (int)__hip_atomic_fetch_add(CNT + ea, 1u, RLX_AGENT), pb = (int)__hip_atomic_fetch_add(CNT + eb, 1u, RLX_AGENT);
                LIST[ea * S + pa] = 2 * m; LIST[eb * S + pb] = 2 * m + 1; EW[2 * m] = w0; EW[2 * m + 1] = w1; }
        }
    }
    __syncthreads();
}

__device__ __forceinline__ void phase8(Ctx& F) {
    build_mts(F);
    volatile LAS int* mts = (volatile LAS int*)(F.lds + LDSCTL_OFF) + 64;
    const int gw = F.vcu * NWAVES + F.wave, NGW = F.G * NWAVES, lane = F.lane;
    const int total = mts[32] * 256;
    const bf16* XN = (const bf16*)(F.ws + WS_XN); bf16* XG = (bf16*)(F.ws + WS_XG); const float* EW = (const float*)(F.ws + WS_EW); const int* LIST = (const int*)(F.ws + WS_LIST);
    int2* DESC = (int2*)(F.ws + WS_DESC); const gu32* CNT = (const gu32*)(F.ws + WS_CTL) + CW_CNT;
    for (int row = gw; row < total; row += NGW) {
        const int mt = row >> 8; int e = 0;
        for (int j = 1; j < 32; ++j) e += (mts[j] <= mt) ? 1 : 0;
        const int pos = row - 256 * mts[e]; const int cnt = (int)__hip_atomic_load(CNT + e, RLX_AGENT);
        GAS v4u* dst = (GAS v4u*)(XG + (size_t)row * DM) + lane;
        if (pos < cnt) { const int ent = LIST[e * S + pos]; const GAS v4u* src = (const GAS v4u*)(XN + (size_t)(ent >> 1) * DM) + lane;
#pragma unroll
            for (int i = 0; i < 4; ++i) dst[64 * i] = src[64 * i];
            if (lane == 0) DESC[row] = make_int2(ent, __float_as_int(EW[ent])); }
        else {
#pragma unroll
            for (int i = 0; i < 4; ++i) dst[64 * i] = (v4u){0u, 0u, 0u, 0u};
            if (lane == 0) DESC[row] = make_int2(-1, 0); }
    }
}

__device__ __forceinline__ void phase11(Ctx& F, bool to_scratch = false) {
    LAS float* gf = (LAS float*)(F.lds + RING_OFF);
    const float* MOD = (const float*)(F.ws + WS_MOD);
    for (int n = F.tid; n < DM; n += NTHREADS) gf[n] = MOD[5 * DM + n] * F.in[I_GPOSTF][n];
    __syncthreads();
    const int gw = F.vcu * NWAVES + F.wave, NGW = F.G * NWAVES, lane = F.lane;
    const float* YE = (const float*)(F.ws + WS_YE);
    float delta = 0.f;
#if defined(TIME_A)
    { const unsigned long long* ts = (const unsigned long long*)((const gu32*)(F.ws + WS_CTL) + CW_TS); delta = 1e-5f * (float)(ts[TIME_B] - ts[TIME_A]); }
#endif
#if defined(ATT_DIAG)
    { const gu32* dg = (const gu32*)(F.ws + WS_CTL) + CW_DIAG; const unsigned ca = __hip_atomic_load(dg + 0, RLX_AGENT), cb = __hip_atomic_load(dg + 1, RLX_AGENT);
      const float mx = __uint_as_float(__hip_atomic_load(dg + 2, RLX_AGENT));
      unsigned best = 0, bi = 0, tot = 0; for (int q = 0; q < 256; ++q) { const unsigned c = __hip_atomic_load(dg + 16 + q, RLX_AGENT); tot += c; if (c > best) { best = c; bi = q; } }
      unsigned hbest = 0, hbi = 0; for (int q = 0; q < 16; ++q) { const unsigned c = __hip_atomic_load(dg + 16 + 256 + q, RLX_AGENT); if (c > hbest) { hbest = c; hbi = q; } }
      delta = ATT_DIAG_MODE == 0 ? 0.05f * log2f(1.0f + (float)ca) : ATT_DIAG_MODE == 1 ? 0.05f * log2f(1.0f + (float)cb) : ATT_DIAG_MODE == 2 ? mx :
              ATT_DIAG_MODE == 3 ? 0.01f * (float)(bi + 1) : ATT_DIAG_MODE == 4 ? (float)best / (float)(tot + 1) : ATT_DIAG_MODE == 5 ? 0.05f * (float)(hbi + 1) : (float)hbest / (float)(tot + 1); }
#endif
    for (int m = gw; m < S; m += NGW) {
        const GAS f32x4* a = (const GAS f32x4*)(YE + (size_t)(2 * m) * DM) + lane; const GAS f32x4* b = (const GAS f32x4*)(YE + (size_t)(2 * m + 1) * DM) + lane;
        const GAS f32x4* xi = (const GAS f32x4*)(F.out + (size_t)m * DM) + lane;
        GAS f32x4* xo = (GAS f32x4*)((to_scratch ? (float*)(F.ws + WS_TMPA) : F.out) + (size_t)m * DM) + lane;
        f32x4 v[8]; float s2 = 0.f;
#pragma unroll
        for (int j = 0; j < 8; ++j) { v[j] = a[64 * j] + b[64 * j]; s2 += (v[j].x * v[j].x + v[j].y * v[j].y) + (v[j].z * v[j].z + v[j].w * v[j].w); }
        const float rstd = 1.0f / sqrtf(wave_sum(s2) * (1.0f / DM) + RMS_EPS);
#pragma unroll
        for (int j = 0; j < 8; ++j) { const int d = 4 * lane + 256 * j; const f32x4 g4 = *(const LAS f32x4*)(gf + d); xo[64 * j] = xi[64 * j] + g4 * (v[j] * rstd) + delta; }
    }
    __syncthreads();
}

struct Args { const float* in[20]; float* out; unsigned char* ws; int ph_lo, ph_hi, li, pad; };
__global__ void __launch_bounds__(NTHREADS, 2) mega_fwd(Args args) {
    extern __shared__ __attribute__((aligned(16))) unsigned char lds[];
    Ctx F;
#pragma unroll
    for (int i = 0; i < 20; ++i) F.in[i] = args.in[i];
    F.out = args.out; F.ws = args.ws;
    F.lds = (LAS unsigned char*)lds;
    F.tid = threadIdx.x; F.lane = F.tid & 63; F.wave = __builtin_amdgcn_readfirstlane(F.tid >> 6);
    F.G = gridDim.x; { const int bx = blockIdx.x; F.vcu = (F.G % 8 == 0) ? (bx % 8) * (F.G / 8) + bx / 8 : bx; }
    volatile LAS unsigned* MISC = (volatile LAS unsigned*)(F.lds + LDSCTL_OFF);
    for (int u = F.tid; u < 256; u += NTHREADS) MISC[u] = 0u;
    __syncthreads();
    gu32* ctl = (gu32*)(F.ws + WS_CTL);
    XcdBarrier bar; bar.bar = (unsigned*)(ctl + CW_BAR); bar.x = 0; bar.st = nullptr;
    if (N_LAUNCHES != PER_PHASE) bar = xcd_barrier_post((unsigned*)(ctl + CW_BAR), MISC + 8);
    const int lo = args.ph_lo, hi = args.ph_hi;
#if defined(TIME_A)
#define STAMP(k) do { if (blockIdx.x == 0 && F.tid == 0) { const unsigned long long t_ = __builtin_amdgcn_s_memrealtime(); ((unsigned long long*)(ctl + CW_TS))[k] = t_; } } while (0)
#else
#define STAMP(k) do {} while (0)
#endif
    STAMP(0);
#ifndef PH_MASK
#define PH_MASK 0xfff
#endif
#define IN(k) (((PH_MASK >> (k)) & 1) && lo <= (k) && (k) < hi)
#define SEAM(k) do { if (IN(k) && IN((k) + 1)) xcd_barrier(bar); } while (0)
    unsigned char* ws = F.ws;
#ifndef REPEAT_MASK
#define REPEAT_MASK 0
#endif
#define REP(k) (((REPEAT_MASK >> (k)) & 1) ? 2 : 1)
    if (IN(0)) { for (int rep = 0; rep < REP(0); ++rep) phase0(F); SEAM(0); STAMP(1); }
    if (IN(1)) { for (int rep = 0; rep < REP(1); ++rep) phase1(F); SEAM(1); STAMP(2); }
    if (IN(2)) { pg8::Gemm g{(const pg8::bf16_t*)(ws + WS_XN), (const pg8::bf16_t*)(ws + WS_WT_IN), S, NIN, DM}; pg8::StaticOrder so; so.init(S, NIN, F.G, (int)blockIdx.x);
        EpiQKVG E{ws}; for (int rep = 0; rep < REP(2); ++rep) run_gemm(F, g, so, E); if (IN(2) && IN(4)) xcd_barrier(bar); STAMP(3); }
#if defined(ATT_DIAG)
    if (IN(4)) { attn_naive(F, 0, 2 * S * NH); __syncthreads(); attn_fast(F, true, true, WS_Y); __syncthreads(); attn_fast(F, true, true, WS_TMPA); xcd_barrier(bar); attn_diag_compare(F); SEAM(4); STAMP(5); }
#elif FAST_ATTN == 1
    if (IN(4)) { for (int rep = 0; rep < REP(4); ++rep) attn_fast(F, true, true); SEAM(4); STAMP(5); }
#elif FAST_ATTN == 2
    if (IN(4)) { attn_fast(F, true, false); __syncthreads(); attn_naive(F, S * NH, 2 * S * NH); SEAM(4); STAMP(5); }
#elif FAST_ATTN == 3
    if (IN(4)) { attn_fast(F, false, true); __syncthreads(); attn_naive(F, 0, S * NH); SEAM(4); STAMP(5); }
#else
    if (IN(4)) { attn_naive(F, 0, 2 * S * NH); SEAM(4); STAMP(5); }
#endif
    if (IN(5)) { pg8::Gemm g{(const pg8::bf16_t*)(ws + WS_OAB), (const pg8::bf16_t*)(ws + WS_WT_OAB), 2 * S, 2 * DM, 1024}; GateOrder go; go.init(F.G, (int)blockIdx.x);
        EpiGate E{ws}; for (int rep = 0; rep < REP(5); ++rep) run_gemm(F, g, go, E); SEAM(5); STAMP(6); }
    if (IN(6)) { pg8::Gemm g{(const pg8::bf16_t*)(ws + WS_Y1), (const pg8::bf16_t*)(ws + WS_WT_OUT), S, DM, DM}; pg8::StaticOrder so; so.init(S, DM, F.G, (int)blockIdx.x);
        EpiY E{ws}; for (int rep = 0; rep < REP(6); ++rep) run_gemm(F, g, so, E); SEAM(6); STAMP(7); }
    if (IN(7)) { for (int rep = 0; rep < REP(7); ++rep) phase7(F, rep == REP(7) - 1); if (IN(7) && IN(9)) xcd_barrier(bar); STAMP(8); }
    if (IN(9)) { build_mts(F); pg8::Gemm g{(const pg8::bf16_t*)(ws + WS_XN), (const pg8::bf16_t*)(ws + WS_WT_GU), S, NEXP * 1024, DM};
        MoeOrder<true> mo{(const volatile LAS int*)(F.lds + LDSCTL_OFF) + 64, 2, F.G, F.vcu, (const int*)(ws + WS_LIST)}; EpiGU E{ws}; for (int rep = 0; rep < REP(9); ++rep) run_gemm(F, g, mo, E); SEAM(9); STAMP(10); }
    if (IN(10)) { build_mts(F); pg8::Gemm g{(const pg8::bf16_t*)(ws + WS_ACT), (const pg8::bf16_t*)(ws + WS_WT_D), MAXROWS, NEXP * DM, DEXP};
        MoeOrder<false> mo{(const volatile LAS int*)(F.lds + LDSCTL_OFF) + 64, 3, F.G, F.vcu, (const int*)(ws + WS_LIST)}; EpiDown E{ws, (const volatile LAS int*)(F.lds + LDSCTL_OFF) + 64}; for (int rep = 0; rep < REP(10); ++rep) run_gemm(F, g, mo, E); SEAM(10); STAMP(11); }
    if (IN(11)) {
#if defined(EXTRA_BARRIERS)
        for (int eb = 0; eb < EXTRA_BARRIERS; ++eb) xcd_barrier(bar);
#endif
        for (int rep = 0; rep < REP(11); ++rep) phase11(F, rep != REP(11) - 1); }
#undef IN
#undef SEAM
}

extern "C" void kernel_launch(void* const* d_in, const int* in_sizes, int n_in, void* d_out, int out_size, void* d_ws, size_t ws_size, hipStream_t stream) {
    static int grid = 0;
    if (grid == 0) {
        if (n_in != 20 || out_size != S * DM || ws_size < WS_END) { fprintf(stderr, "kernel_launch: unexpected shapes: n_in %d out %d ws %zu (need %zu)\n", n_in, out_size, ws_size, (size_t)WS_END); grid = -1; return; }
        int dev = 0, cus = 0, per_cu = 0;
        if (hipGetDevice(&dev) != hipSuccess || hipDeviceGetAttribute(&cus, hipDeviceAttributeMultiprocessorCount, dev) != hipSuccess) { fprintf(stderr, "kernel_launch: device query failed\n"); grid = -1; return; }
        if (hipFuncSetAttribute((const void*)mega_fwd, hipFuncAttributeMaxDynamicSharedMemorySize, LDS_BYTES) != hipSuccess) { fprintf(stderr, "kernel_launch: hipFuncSetAttribute failed\n"); grid = -1; return; }
        if (hipOccupancyMaxActiveBlocksPerMultiprocessor(&per_cu, (const void*)mega_fwd, NTHREADS, LDS_BYTES) != hipSuccess || per_cu < 1) { fprintf(stderr, "kernel_launch: occupancy query says %d blocks per CU\n", per_cu); grid = -1; (void)hipGetLastError(); return; }
        grid = cus;
        fprintf(stderr, "kernel_launch: grid %d (occupancy query: %d per CU)\n", grid, per_cu);
    }
    if (grid < 0) return;
    if (hipMemsetAsync((char*)d_ws + WS_CTL, 0, CTL_ZERO_BYTES, stream) != hipSuccess) { fprintf(stderr, "kernel_launch: memset failed\n"); return; }
    Args a{};
    for (int i = 0; i < 20; ++i) a.in[i] = (const float*)d_in[i];
    a.out = (float*)d_out; a.ws = (unsigned char*)d_ws;
    if (N_LAUNCHES == 1) {
        a.ph_lo = 0; a.ph_hi = PER_PHASE; a.li = 0;
        void* kargs[] = {&a};
        hipError_t e = hipLaunchCooperativeKernel((const void*)mega_fwd, dim3(grid), dim3(NTHREADS), kargs, LDS_BYTES, stream);
        if (e != hipSuccess) fprintf(stderr, "kernel_launch: cooperative launch failed: %s (grid %d)\n", hipGetErrorString(e), grid);
    } else {
        for (int li = 0; li < PER_PHASE; ++li) { a.ph_lo = li; a.ph_hi = li + 1; a.li = li;
            hipLaunchKernelGGL(mega_fwd, dim3(grid), dim3(NTHREADS), LDS_BYTES, stream, a);
            const hipError_t le = hipPeekAtLastError(); if (le != hipSuccess) { fprintf(stderr, "kernel_launch: launch %d failed: %s\n", li, hipGetErrorName(le)); break; } }
    }
}
```
